# Optimizing an MI355X kernel written in HIP

```python
import jax, jax.numpy as jnp
from jax import lax
import numpy as np

D_MODEL = 2048
BATCH = 4
SEQ = 2048
DEPTH = 2

CTX_LEN = 256
GRID_W = 64
HEAD_DIM = 128
D_MIX = D_MODEL
N_NA_HEADS = 12
NA_WIDTH = N_NA_HEADS * HEAD_DIM
N_FOUR_GROUPS = 4
FOUR_DIM = 128
FOUR_WIDTH = N_FOUR_GROUPS * FOUR_DIM
IN_WIDTH = 3 * NA_WIDTH + FOUR_WIDTH
WIN_ROWS = 8
WIN_COLS = 16
D_FF = 5632
N_MOD = 9
EPS = 1e-6

kernel_name = "hybrid_na_fnet_macaron_dit_block"


def _rms(x, w):
    xf = x.astype(jnp.float32)
    y = xf * lax.rsqrt(jnp.mean(xf * xf, axis=-1, keepdims=True) + EPS)
    return (y * w.astype(jnp.float32)).astype(x.dtype)


def _modulate(xn, shift, scale):
    return xn * (1 + scale) + shift


def _swiglu(h, wi, wo):
    g, u = jnp.split(h @ wi, 2, axis=-1)
    return (jax.nn.silu(g) * u) @ wo


def _heads(t, gain=None):
    B, L, _ = t.shape
    t = t.reshape(B, L, N_NA_HEADS, HEAD_DIM)
    return t if gain is None else _rms(t, gain)


def _fourier(f, w_four):
    B, L, _ = f.shape
    fg = f.reshape(B, L, N_FOUR_GROUPS, FOUR_DIM).transpose(0, 2, 1, 3).astype(jnp.float32)
    mixed = jnp.fft.fft2(fg, axes=(-2, -1), norm="ortho").real.astype(f.dtype)
    out = jnp.einsum('bglc,gcd->blgd', mixed, w_four)
    return out.reshape(B, L, FOUR_WIDTH)


def _ctx_attn(qc, kc, vc):
    B, L, H, Dh = qc.shape
    s = jnp.einsum('bqhd,bkhd->bhqk', qc, kc).astype(jnp.float32) * (Dh ** -0.5)
    p = jax.nn.softmax(s, axis=-1).astype(vc.dtype)
    return jnp.einsum('bhqk,bkhd->bqhd', p, vc).reshape(B, L, H * Dh)


def _na_latent(q, k, v, kc, vc, rpb, rows):
    B, N, H, Dh = q.shape
    kh = min(WIN_ROWS, rows)
    kw = WIN_COLS

    def grid(t):
        return t.reshape(B, rows, GRID_W, H, Dh).transpose(0, 3, 1, 2, 4)

    qg, kg, vg = grid(q), grid(k), grid(v)
    r = jnp.arange(rows)
    row_start = jnp.clip(r - kh // 2, 0, rows - kh)
    row_idx = row_start[:, None] + jnp.arange(kh)
    k_rows = jnp.take(kg, row_idx, axis=2)
    v_rows = jnp.take(vg, row_idx, axis=2)

    col = jnp.arange(GRID_W)
    col_start = jnp.clip(col - kw // 2, 0, GRID_W - kw)
    col_in = (col[None, :] >= col_start[:, None]) & (col[None, :] < col_start[:, None] + kw)
    dr = row_idx - r[:, None] + (WIN_ROWS - 1)
    dc = jnp.clip(col[None, :] - col[:, None], -(kw - 1), kw - 1) + (WIN_COLS - 1)
    bias = rpb[:, dr[:, None, :, None], dc[None, :, None, :]]

    scale = Dh ** -0.5
    s_win = jnp.einsum('bhrqd,bhrikd->bhrqik', qg, k_rows).astype(jnp.float32) * scale \
        + bias.astype(jnp.float32)
    s_win = jnp.where(col_in[:, None, :], s_win, -jnp.inf)
    s_ctx = jnp.einsum('bhrqd,bchd->bhrqc', qg, kc).astype(jnp.float32) * scale
    s = jnp.concatenate([s_win.reshape(B, H, rows, GRID_W, kh * GRID_W), s_ctx], axis=-1)
    p = jax.nn.softmax(s, axis=-1).astype(v.dtype)
    p_win = p[..., :kh * GRID_W].reshape(B, H, rows, GRID_W, kh, GRID_W)
    p_ctx = p[..., kh * GRID_W:]
    o = jnp.einsum('bhrqik,bhrikd->bhrqd', p_win, v_rows) \
        + jnp.einsum('bhrqc,bchd->bhrqd', p_ctx, vc)
    return o.transpose(0, 2, 3, 1, 4).reshape(B, N, H * Dh)


def setup_inputs(seed: int = 0) -> dict:
    key = jax.random.key(seed)
    ks = jax.random.split(key, 17)

    def nrm(k, shape, s):
        return jax.random.normal(k, shape, jnp.float32) * s

    return {
        "x": nrm(ks[0], (BATCH, SEQ, D_MODEL), 1.0),
        "c": nrm(ks[1], (BATCH, D_MODEL), 1.0),
        "ctx": nrm(ks[2], (BATCH, CTX_LEN, D_MODEL), 1.0),
        "c_ctx": nrm(ks[3], (D_MODEL,), 1.0),
        "w_mod": nrm(ks[4], (DEPTH, D_MODEL, N_MOD * D_MODEL), 0.5 * D_MODEL ** -0.5),
        "b_mod": nrm(ks[5], (DEPTH, N_MOD * D_MODEL), 0.02),
        "norm_w": 1.0 + nrm(ks[6], (DEPTH, 3, D_MODEL), 0.1),
        "ffn1_wi": nrm(ks[7], (DEPTH, D_MODEL, 2 * D_FF), D_MODEL ** -0.5),
        "ffn1_wo": nrm(ks[8], (DEPTH, D_FF, D_MODEL), D_FF ** -0.5),
        "w_in": nrm(ks[9], (DEPTH, D_MODEL, IN_WIDTH), D_MODEL ** -0.5),
        "q_norm_w": 1.0 + nrm(ks[10], (DEPTH, HEAD_DIM), 0.1),
        "k_norm_w": 1.0 + nrm(ks[11], (DEPTH, HEAD_DIM), 0.1),
        "rpb": nrm(ks[12], (DEPTH, N_NA_HEADS, 2 * WIN_ROWS - 1, 2 * WIN_COLS - 1), 0.5),
        "w_four": nrm(ks[13], (DEPTH, N_FOUR_GROUPS, FOUR_DIM, FOUR_DIM), FOUR_DIM ** -0.5),
        "w_out": nrm(ks[14], (DEPTH, D_MIX, D_MODEL), D_MIX ** -0.5),
        "ffn2_wi": nrm(ks[15], (DEPTH, D_MODEL, 2 * D_FF), D_MODEL ** -0.5),
        "ffn2_wo": nrm(ks[16], (DEPTH, D_FF, D_MODEL), D_FF ** -0.5),
    }


def reference(x, c, ctx, c_ctx, w_mod, b_mod, norm_w, ffn1_wi, ffn1_wo, w_in,
              q_norm_w, k_norm_w, rpb, w_four, w_out, ffn2_wi, ffn2_wo):
    B, N, D = x.shape
    rows = N // GRID_W
    xc = ctx
    for l in range(DEPTH):
        last = l == DEPTH - 1
        m = [t[:, None, :] for t in jnp.split(jax.nn.silu(c) @ w_mod[l] + b_mod[l], N_MOD, axis=-1)]
        mc = jnp.split(jax.nn.silu(c_ctx) @ w_mod[l] + b_mod[l], N_MOD, axis=-1)

        x = x + 0.5 * m[2] * _swiglu(_modulate(_rms(x, norm_w[l, 0]), m[0], m[1]), ffn1_wi[l], ffn1_wo[l])
        xc = xc + 0.5 * mc[2] * _swiglu(_modulate(_rms(xc, norm_w[l, 0]), mc[0], mc[1]), ffn1_wi[l], ffn1_wo[l])

        h = _modulate(_rms(x, norm_w[l, 1]), m[3], m[4]) @ w_in[l]
        q, k, v, f = jnp.split(h, [NA_WIDTH, 2 * NA_WIDTH, 3 * NA_WIDTH], axis=-1)
        hcn = _modulate(_rms(xc, norm_w[l, 1]), mc[3], mc[4])
        if last:
            kc, vc = jnp.split(hcn @ w_in[l][:, NA_WIDTH:3 * NA_WIDTH], 2, axis=-1)
        else:
            qc, kc, vc, fc = jnp.split(hcn @ w_in[l], [NA_WIDTH, 2 * NA_WIDTH, 3 * NA_WIDTH], axis=-1)
        kc_h = _heads(kc, k_norm_w[l])
        vc_h = _heads(vc)

        na = _na_latent(_heads(q, q_norm_w[l]), _heads(k, k_norm_w[l]), _heads(v), kc_h, vc_h, rpb[l], rows)
        y = jnp.concatenate([na, _fourier(f, w_four[l])], axis=-1) @ w_out[l]
        x = x + m[5] * y

        if not last:
            nac = _ctx_attn(_heads(qc, q_norm_w[l]), kc_h, vc_h)
            yc = jnp.concatenate([nac, _fourier(fc, w_four[l])], axis=-1) @ w_out[l]
            xc = xc + mc[5] * yc
            xc = xc + 0.5 * mc[8] * _swiglu(_modulate(_rms(xc, norm_w[l, 2]), mc[6], mc[7]), ffn2_wi[l], ffn2_wo[l])

        x = x + 0.5 * m[8] * _swiglu(_modulate(_rms(x, norm_w[l, 2]), m[6], m[7]), ffn2_wi[l], ffn2_wo[l])
    return x
```

```cpp
#include <hip/hip_runtime.h>
#include <hip/hip_cooperative_groups.h>
#include <cstdio>
namespace cg = cooperative_groups;

#define LAS __attribute__((address_space(3)))
typedef unsigned short bf16_t;
typedef short bf16x8 __attribute__((ext_vector_type(8)));
typedef float f32x4 __attribute__((ext_vector_type(4)));
typedef float f32x2 __attribute__((ext_vector_type(2)));
typedef unsigned u32x4 __attribute__((ext_vector_type(4)));
typedef unsigned u32x2 __attribute__((ext_vector_type(2)));

#ifndef MULTI_LAUNCH
#define MULTI_LAUNCH 0
#endif
#ifndef REP_PH
#define REP_PH (-1)
#endif
#ifndef REP_N
#define REP_N 0
#endif
#define ATT_REP 1
#define DFT_REP 1
#define SYNC_REP 1
#define TAIL_REP 1
#define MAIN_REP 1
#define NORM_REP 1

constexpr int D = 2048, TL = 8192, TC = 1024, T = TL + TC, FF = 5632, NMODC = 9 * 2048;
constexpr int NTHR = 512;
constexpr int LDS_STAGE = 131072;
constexpr int LDS_BYTES = LDS_STAGE + 64;
constexpr float LOG2E = 1.4426950408889634f;

constexpr size_t SZ_MOD = (size_t)2 * 5 * NMODC * 4;
constexpr size_t OFF_BAR = 0;
constexpr size_t SZ_BAR = 16384;
constexpr size_t OFF_MOD = OFF_BAR + SZ_BAR;
constexpr size_t OFF_WCS = OFF_MOD + SZ_MOD;
constexpr size_t OFF_X = OFF_WCS + (size_t)2 * 4 * 2 * 128 * 128 * 4;
constexpr size_t OFF_A = OFF_X + (size_t)T * D * 4;
constexpr size_t OFF_H = OFF_A + (size_t)T * D * 2;
constexpr size_t OFF_QK = OFF_H + (size_t)T * FF * 2;
constexpr size_t OFF_VTL = OFF_QK + (size_t)T * 3072 * 2;
constexpr size_t OFF_VTC = OFF_VTL + (size_t)4 * 1536 * 2048 * 2;
constexpr size_t OFF_UTL = OFF_VTC + (size_t)4 * 1536 * 256 * 2;
constexpr size_t OFF_UTC = OFF_UTL + (size_t)2048 * 4096 * 2;
constexpr size_t OFF_CAT = OFF_UTC + (size_t)2048 * 512 * 2;
constexpr size_t OFF_DFTL = OFF_CAT + (size_t)T * D * 2;
constexpr size_t OFF_DFTC = OFF_DFTL + (size_t)2048 * 4096 * 2;
constexpr size_t OFF_W = OFF_DFTC + (size_t)256 * 512 * 2;
constexpr size_t WSZ_WI = (size_t)2 * FF * D * 2, WSZ_WO = (size_t)D * FF * 2, WSZ_QK = (size_t)3072 * D * 2, WSZ_VF = (size_t)2560 * D * 2, WSZ_OUT = (size_t)D * D * 2;
constexpr size_t WO_WI1 = 0, WO_WO1 = WO_WI1 + WSZ_WI, WO_QK = WO_WO1 + WSZ_WO, WO_VF = WO_QK + WSZ_QK, WO_OUT = WO_VF + WSZ_VF, WO_WI2 = WO_OUT + WSZ_OUT, WO_WO2 = WO_WI2 + WSZ_WI;
constexpr size_t WSZ_LAYER = WO_WO2 + WSZ_WO;
constexpr size_t OFF_PART = OFF_W + 2 * WSZ_LAYER;
constexpr size_t OFF_DUMMY = OFF_PART + (size_t)8 * 32 * 65536 * 4;
constexpr size_t WS_END = OFF_DUMMY + (size_t)T * D * 4;

struct Params {
    const float* x; const float* c; const float* ctx; const float* c_ctx; const float* w_mod; const float* b_mod; const float* norm_w;
    const float* ffn1_wi; const float* ffn1_wo; const float* w_in; const float* q_norm_w; const float* k_norm_w; const float* rpb; const float* w_four;
    const float* w_out; const float* ffn2_wi; const float* ffn2_wo;
    float* out; unsigned char* ws; int ph_lo, ph_hi;
};

typedef const __attribute__((address_space(4))) Params* PP;

__device__ __forceinline__ unsigned pk_bf16(float lo, float hi) { unsigned r; asm("v_cvt_pk_bf16_f32 %0, %1, %2" : "=v"(r) : "v"(lo), "v"(hi)); return r; }
__device__ __forceinline__ float bf_lo(unsigned u) { return __uint_as_float(u << 16); }
__device__ __forceinline__ float bf_hi(unsigned u) { return __uint_as_float(u & 0xffff0000u); }

namespace pg8 {
constexpr int BM = 256, BK = 64, HALF = 128, HTB = HALF * BK * 2, NXCD = 8, WGM = 8;
__device__ __forceinline__ int lds_byte(int r, int c) { const int st = (r >> 4) * 2 + (c >> 5), rr = r & 15, cc = c & 31, ob = rr * 64 + cc * 2; return st * 1024 + (ob ^ (((ob >> 9) & 1) << 5)); }
__device__ __forceinline__ void stage_rc(int b, int& R, int& C) { const int st = b / 1024, sb = b % 1024, swz = sb ^ (((sb >> 9) & 1) << 5); R = (st >> 1) * 16 + swz / 64; C = (st & 1) * 32 + (swz % 64) / 2; }
__device__ __forceinline__ int perm32(int rho) { const int n = rho >> 4, i = rho & 15; return 8 * (i >> 2) + 4 * n + (i & 3); }

struct Unit { const char* a; const char* b; int pm, pn, kind; };
__device__ __forceinline__ unsigned mkpk(int pm0, int nM, int pn0, int nN, int kind) { return (unsigned)pm0 | ((unsigned)nM << 6) | ((unsigned)pn0 << 12) | ((unsigned)nN << 18) | ((unsigned)kind << 24); }
struct MSched {
    const bf16_t* A0; const bf16_t* B0; const bf16_t* A1; const bf16_t* B1; const bf16_t* A2; const bf16_t* B2; const bf16_t* A3; const bf16_t* B3;
    unsigned pk0, pk1, pk2, pk3; int st1, st2, st3; int total, G, c; size_t tstep; size_t koff;
    __device__ __forceinline__ bool next(int i, Unit& u) const {
        const int L = i * G + c; if (L >= total) return false;
        const bf16_t* sA = A0; const bf16_t* sB = B0; unsigned spk = pk0; int sst = 0;
        if (L >= st1) { sA = A1; sB = B1; spk = pk1; sst = st1; }
        asm volatile("" : "+s"(sA), "+s"(sB), "+s"(spk), "+s"(sst));
        if (L >= st2) { sA = A2; sB = B2; spk = pk2; sst = st2; }
        asm volatile("" : "+s"(sA), "+s"(sB), "+s"(spk), "+s"(sst));
        if (L >= st3) { sA = A3; sB = B3; spk = pk3; sst = st3; }
        asm volatile("" : "+s"(sA), "+s"(sB), "+s"(spk), "+s"(sst));
        const int s_pm0 = spk & 63, s_nM = (spk >> 6) & 63, s_pn0 = (spk >> 12) & 63, s_nN = (spk >> 18) & 63, s_kind = spk >> 24;
        int wgid = L - sst; const int nwg = s_nM * s_nN;
        { const int q = nwg / NXCD, r = nwg % NXCD, xcd = wgid % NXCD, off = wgid / NXCD; wgid = (xcd < r ? xcd * (q + 1) : r * (q + 1) + (xcd - r) * q) + off; }
        const int nig = WGM * s_nN, gid = wgid / nig, fm = gid * WGM, gsz = (s_nM - fm) < WGM ? (s_nM - fm) : WGM;
        u.pm = s_pm0 + fm + ((wgid % nig) % gsz); u.pn = s_pn0 + (wgid % nig) / gsz; u.kind = s_kind;
        u.a = (const char*)sA + (size_t)u.pm * tstep + koff; u.b = (const char*)sB + (size_t)u.pn * tstep + koff; return true;
    }
};
__device__ __forceinline__ MSched sched1(const bf16_t* A, const bf16_t* Bt, int nM, int nN, int kind, int G, int c, size_t tstep) {
    MSched S; S.A0 = A; S.B0 = Bt; S.A1 = A; S.B1 = Bt; S.A2 = A; S.B2 = Bt; S.A3 = A; S.B3 = Bt; S.pk0 = S.pk1 = S.pk2 = S.pk3 = mkpk(0, nM, 0, nN, kind);
    S.st1 = S.st2 = S.st3 = 0x7fffffff; S.total = nM * nN; S.G = G; S.c = c; S.tstep = tstep; S.koff = 0; return S; }

template <class Epi>
__device__ __forceinline__ void gemm_phase(LAS unsigned char* lds, const int tid, const int K, const int ld, const MSched& S, const Epi& E) {
    const int wid = __builtin_amdgcn_readfirstlane(tid >> 6), lane = tid & 63, wr = wid >> 2, wc = wid & 3, fr = lane & 15, fq = lane >> 4;
    const int nt = K / BK;
    unsigned voffA[2], voffB[2];
#pragma unroll
    for (int i = 0; i < 2; ++i) { int R, C; stage_rc(tid * 16 + i * 8192, R, C); const int Rb = Epi::PERM ? ((R & ~31) + perm32(R & 31)) : R;
        voffA[i] = (unsigned)(R * ld + C) * 2u; voffB[i] = (unsigned)(Rb * ld + C) * 2u; }
    const size_t kstep = (size_t)(BK * 2);
    const size_t hstep = (size_t)HALF * ld * 2;
    const unsigned ldsw = (unsigned)wid * 1024u;
    const int aoff = lds_byte(wr * 64 + fr, fq * 8), boff = lds_byte(wc * 32 + fr, fq * 8);
#define PG8_SA(b, h) (((b) * 2 + (h)) * HTB)
#define PG8_SB(b, h) ((4 + (b) * 2 + (h)) * HTB)
#define PG8_STAGE(bufoff, gbase, voff) do { _Pragma("unroll") for (int _i = 0; _i < 2; ++_i) \
        __builtin_amdgcn_global_load_lds((const unsigned*)((const char*)(gbase) + (voff)[_i]), (LAS unsigned*)(lds + (bufoff) + ldsw + _i * 8192), 16, 0, 0); } while (0)
#define PG8_LDA(dst, b, h) do { _Pragma("unroll") for (int m = 0; m < 4; ++m) _Pragma("unroll") for (int k = 0; k < 2; ++k) dst[m][k] = *(const LAS bf16x8*)(lds + PG8_SA(b, h) + aoff + m * 2048 + k * 1024); } while (0)
#define PG8_LDB(dst, b, h) do { _Pragma("unroll") for (int n = 0; n < 2; ++n) _Pragma("unroll") for (int k = 0; k < 2; ++k) dst[n][k] = *(const LAS bf16x8*)(lds + PG8_SB(b, h) + boff + n * 2048 + k * 1024); } while (0)
#define PG8_MMA(ai, bj, At, Bt) do { __builtin_amdgcn_s_setprio(1); _Pragma("unroll") for (int m = 0; m < 4; ++m) _Pragma("unroll") for (int n = 0; n < 2; ++n) _Pragma("unroll") for (int k = 0; k < 2; ++k) \
        acc[ai][bj][m][n] = __builtin_amdgcn_mfma_f32_16x16x32_bf16(Bt[n][k], At[m][k], acc[ai][bj][m][n], 0, 0, 0); __builtin_amdgcn_s_setprio(0); } while (0)
#define PG8_WAIT_V(n) asm volatile("s_waitcnt vmcnt(" #n ")" ::: "memory")
#define PG8_WAIT_L(n) asm volatile("s_waitcnt lgkmcnt(" #n ")" ::: "memory")
#define PG8_BAR __builtin_amdgcn_s_barrier()
#define PG8_SCHED __builtin_amdgcn_sched_barrier(0)
    Unit cur, nxt; int ui = 0;
    if (!S.next(0, cur)) return;
    f32x4 acc[2][2][4][2];
#pragma unroll
    for (int a = 0; a < 2; ++a)
#pragma unroll
        for (int b = 0; b < 2; ++b)
#pragma unroll
            for (int m = 0; m < 4; ++m)
#pragma unroll
                for (int n = 0; n < 2; ++n) acc[a][b][m][n] = (f32x4){0.f, 0.f, 0.f, 0.f};
    bf16x8 At[4][2], B0[2][2], B1[2][2];
    const char* cA = cur.a; const char* cB = cur.b;
    PG8_STAGE(PG8_SB(0, 0), cB, voffB); PG8_STAGE(PG8_SA(0, 0), cA, voffA); PG8_STAGE(PG8_SB(0, 1), cB + hstep, voffB); PG8_STAGE(PG8_SA(0, 1), cA + hstep, voffA);
    if (wr == 1) PG8_BAR;
    PG8_WAIT_V(4); PG8_BAR;
    PG8_STAGE(PG8_SB(1, 0), cB + kstep, voffB); PG8_STAGE(PG8_SA(1, 0), cA + kstep, voffA); PG8_STAGE(PG8_SB(1, 1), cB + hstep + kstep, voffB);
    PG8_WAIT_V(6); PG8_BAR;
    for (;;) {
        const bool has_next = S.next(ui + 1, nxt);
        const char* nA = has_next ? nxt.a : cA; const char* nB = has_next ? nxt.b : cB;
        for (int t = 0; t < nt; t += 2) {
            const bool last = (t == nt - 2);
            const char* a1 = cA + (size_t)(t + 1) * kstep;
            const char* a2 = last ? nA : cA + (size_t)(t + 2) * kstep; const char* b2 = last ? nB : cB + (size_t)(t + 2) * kstep;
            const char* a3 = a2 + kstep; const char* b3 = b2 + kstep;
            PG8_LDB(B0, 0, 0); PG8_SCHED; PG8_LDA(At, 0, 0); PG8_STAGE(PG8_SA(1, 1), a1 + hstep, voffA);
            PG8_WAIT_L(8); PG8_BAR; PG8_WAIT_L(0); PG8_MMA(0, 0, At, B0); PG8_BAR; PG8_SCHED;
            PG8_LDB(B1, 0, 1); PG8_STAGE(PG8_SB(0, 0), b2, voffB);
            PG8_BAR; PG8_WAIT_L(0); PG8_MMA(0, 1, At, B1); PG8_BAR;
            PG8_LDA(At, 0, 1); PG8_STAGE(PG8_SA(0, 0), a2, voffA);
            PG8_BAR; PG8_WAIT_L(0); PG8_MMA(1, 0, At, B0); PG8_BAR; PG8_SCHED;
            PG8_STAGE(PG8_SB(0, 1), b2 + hstep, voffB);
            PG8_WAIT_V(6); PG8_BAR; PG8_MMA(1, 1, At, B1); PG8_BAR;
            PG8_LDB(B0, 1, 0); PG8_SCHED; PG8_LDA(At, 1, 0); PG8_STAGE(PG8_SA(0, 1), a2 + hstep, voffA);
            PG8_WAIT_L(8); PG8_BAR; PG8_WAIT_L(0); PG8_MMA(0, 0, At, B0); PG8_BAR; PG8_SCHED;
            PG8_LDB(B1, 1, 1); PG8_STAGE(PG8_SB(1, 0), b3, voffB);
            PG8_BAR; PG8_WAIT_L(0); PG8_MMA(0, 1, At, B1); PG8_BAR;
            PG8_LDA(At, 1, 1); PG8_STAGE(PG8_SA(1, 0), a3, voffA);
            PG8_BAR; PG8_WAIT_L(0); PG8_MMA(1, 0, At, B0); PG8_BAR; PG8_SCHED;
            PG8_STAGE(PG8_SB(1, 1), b3 + hstep, voffB);
            PG8_WAIT_V(6); PG8_BAR; PG8_MMA(1, 1, At, B1); PG8_BAR;
        }
        E(acc, cur, wr, wc, fr, fq);
        if (!has_next) break;
#pragma unroll
        for (int a = 0; a < 2; ++a)
#pragma unroll
            for (int b = 0; b < 2; ++b)
#pragma unroll
                for (int m = 0; m < 4; ++m)
#pragma unroll
                    for (int n = 0; n < 2; ++n) acc[a][b][m][n] = (f32x4){0.f, 0.f, 0.f, 0.f};
        cur = nxt; cA = nA; cB = nB; ++ui;
    }
    PG8_WAIT_V(0);
    if (wr == 0) PG8_BAR;
    PG8_BAR;
#undef PG8_SA
#undef PG8_SB
#undef PG8_STAGE
#undef PG8_LDA
#undef PG8_LDB
#undef PG8_MMA
#undef PG8_WAIT_V
#undef PG8_WAIT_L
#undef PG8_BAR
#undef PG8_SCHED
}

struct EpiSwiglu {
    static constexpr bool PERM = true;
    bf16_t* H;
    __device__ __forceinline__ void operator()(const f32x4 (&acc)[2][2][4][2], const Unit& u, int wr, int wc, int fr, int fq) const {
        const int row0 = u.pm * BM + wr * 64 + fr, col0 = u.pn * 128 + wc * 32 + 8 * fq;
#pragma unroll
        for (int ai = 0; ai < 2; ++ai)
#pragma unroll
            for (int m = 0; m < 4; ++m) {
                float h[8];
#pragma unroll
                for (int n = 0; n < 2; ++n)
#pragma unroll
                    for (int j = 0; j < 4; ++j) { const float g = acc[ai][0][m][n][j], uu = acc[ai][1][m][n][j];
                        h[n * 4 + j] = g * __builtin_amdgcn_rcpf(1.0f + __builtin_amdgcn_exp2f(-g * LOG2E)) * uu; }
                u32x4 w; w.x = pk_bf16(h[0], h[1]); w.y = pk_bf16(h[2], h[3]); w.z = pk_bf16(h[4], h[5]); w.w = pk_bf16(h[6], h[7]);
                *(u32x4*)(H + (size_t)(row0 + ai * HALF + m * 16) * FF + col0) = w;
            }
    }
};
struct EpiRes {
    static constexpr bool PERM = false;
    const float* base; float* out_lat; float* out_ctx; const float* gate; float gs; float* part;
    __device__ __forceinline__ void operator()(const f32x4 (&acc)[2][2][4][2], const Unit& u, int wr, int wc, int fr, int fq) const {
        if (part) {
            float* pt = part + (size_t)((u.pm - 32) * 8 + u.pn) * 65536 + (wr * 64 + fr) * 256 + wc * 32 + 4 * fq;
#pragma unroll
            for (int ai = 0; ai < 2; ++ai)
#pragma unroll
                for (int m = 0; m < 4; ++m)
#pragma unroll
                    for (int bj = 0; bj < 2; ++bj)
#pragma unroll
                        for (int n = 0; n < 2; ++n) *(f32x4*)(pt + (ai * HALF + m * 16) * 256 + bj * HALF + n * 16) = acc[ai][bj][m][n];
            return;
        }
        const int row0 = u.pm * BM + wr * 64 + fr, col0 = u.pn * BM + wc * 32 + 4 * fq;
        const bool lat = u.pm < 32; const int b = lat ? (u.pm >> 3) : 4;
        float* out = lat ? out_lat : out_ctx;
        f32x4 gv[2][2];
#pragma unroll
        for (int bj = 0; bj < 2; ++bj)
#pragma unroll
            for (int n = 0; n < 2; ++n) gv[bj][n] = *(const f32x4*)(gate + (size_t)b * NMODC + col0 + bj * HALF + n * 16) * gs;
#pragma unroll
        for (int ai = 0; ai < 2; ++ai)
#pragma unroll
            for (int m = 0; m < 4; ++m) { const size_t off = (size_t)(row0 + ai * HALF + m * 16) * D + col0;
#pragma unroll
                for (int bj = 0; bj < 2; ++bj)
#pragma unroll
                    for (int n = 0; n < 2; ++n) { const f32x4 bs = *(const f32x4*)(base + off + bj * HALF + n * 16);
                        *(f32x4*)(out + off + bj * HALF + n * 16) = bs + gv[bj][n] * acc[ai][bj][m][n]; } }
    }
};
__device__ __forceinline__ u32x4 pack8(const f32x4& a, const f32x4& b) { u32x4 w; w.x = pk_bf16(a[0], a[1]); w.y = pk_bf16(a[2], a[3]); w.z = pk_bf16(b[0], b[1]); w.w = pk_bf16(b[2], b[3]); return w; }
struct EpiWin {
    static constexpr bool PERM = true;
    unsigned char* ws;
    __device__ __forceinline__ void operator()(const f32x4 (&acc)[2][2][4][2], const Unit& u, int wr, int wc, int fr, int fq) const {
        const int row0 = u.pm * BM + wr * 64 + fr, col0 = u.pn * BM + wc * 32 + 8 * fq;
        bf16_t* QK = (bf16_t*)(ws + OFF_QK); bf16_t* VtL = (bf16_t*)(ws + OFF_VTL); bf16_t* VtC = (bf16_t*)(ws + OFF_VTC); bf16_t* UtL = (bf16_t*)(ws + OFF_UTL); bf16_t* UtC = (bf16_t*)(ws + OFF_UTC);
        if (u.kind == 0) {
#pragma unroll
            for (int ai = 0; ai < 2; ++ai)
#pragma unroll
                for (int m = 0; m < 4; ++m)
#pragma unroll
                    for (int bj = 0; bj < 2; ++bj)
                        *(u32x4*)(QK + (size_t)(row0 + ai * HALF + m * 16) * 3072 + col0 + bj * HALF) = pack8(acc[ai][bj][m][0], acc[ai][bj][m][1]);
        } else {
            const bool lat = u.pn < 32; const bool isv = u.pm < 6;
            const int tk0 = lat ? col0 : col0 - TL; const int L = lat ? 2048 : 256; const int lsh = lat ? 11 : 8;
#pragma unroll
            for (int ai = 0; ai < 2; ++ai)
#pragma unroll
                for (int m = 0; m < 4; ++m) { const int f = row0 + ai * HALF + m * 16;
#pragma unroll
                    for (int bj = 0; bj < 2; ++bj) { const int tk = tk0 + bj * HALF, b = tk >> lsh, l = tk & (L - 1);
                        bf16_t* dst;
                        if (isv) dst = (lat ? VtL : VtC) + ((size_t)(b * 1536 + f) << lsh) + l;
                        else { const int f2 = f - 1536, g = f2 >> 8, cs = (f2 >> 7) & 1, d = f2 & 127; dst = (lat ? UtL : UtC) + (((size_t)((b * 4 + g) * 128 + d) * 2 + cs) << lsh) + l; }
                        *(u32x4*)dst = pack8(acc[ai][bj][m][0], acc[ai][bj][m][1]); } }
        }
    }
};
struct EpiDft {
    static constexpr bool PERM = true;
    bf16_t* CAT;
    __device__ __forceinline__ void operator()(const f32x4 (&acc)[2][2][4][2], const Unit& u, int wr, int wc, int fr, int fq) const {
        const int row0 = u.pm * BM + wr * 64 + fr, col0 = u.pn * BM + wc * 32 + 8 * fq;
        const int b = u.pn >> 1; const int tok0 = (u.kind == 0) ? b * 2048 : TL + b * 256;
#pragma unroll
        for (int ai = 0; ai < 2; ++ai)
#pragma unroll
            for (int m = 0; m < 4; ++m)
#pragma unroll
                for (int bj = 0; bj < 2; ++bj)
                    *(u32x4*)(CAT + (size_t)(tok0 + row0 + ai * HALF + m * 16) * D + 1536 + ((col0 + bj * HALF) & 511)) = pack8(acc[ai][bj][m][0], acc[ai][bj][m][1]);
    }
};
}

__device__ __forceinline__ void transpose_unit(LAS unsigned char* lds, const int tid, const float* src, int ldn, int K, int kt, int nt, bf16_t* dst, bf16_t* dst2, int map) {
    LAS float* tile = (LAS float*)lds;
    const int wave = tid >> 6, lane = tid & 63;
    const float* sp = src + (size_t)(kt * 64 + wave) * ldn + nt * 256 + 4 * lane;
    f32x4 v[8];
#pragma unroll
    for (int i = 0; i < 8; ++i) v[i] = __builtin_nontemporal_load((const f32x4*)(sp + (size_t)(8 * i) * ldn));
#pragma unroll
    for (int i = 0; i < 8; ++i) *(LAS f32x4*)(tile + (wave + 8 * i) * 256 + 4 * (lane ^ i)) = v[i];
    __syncthreads();
    const int kc = lane & 7, nl = lane >> 3;
#pragma unroll
    for (int it = 0; it < 4; ++it) {
        const int n = it * 64 + wave * 8 + nl;
        const LAS float* tp = tile + (8 * kc) * 256 + 4 * ((n >> 2) ^ kc) + (n & 3);
        u32x4 w; w.x = pk_bf16(tp[0], tp[256]); w.y = pk_bf16(tp[512], tp[768]); w.z = pk_bf16(tp[1024], tp[1280]); w.w = pk_bf16(tp[1536], tp[1792]);
        const int ng = nt * 256 + n;
        bf16_t* drow;
        if (map == 0) drow = dst + (size_t)ng * K;
        else if (map == 1) { const int isu = ng >= FF, j = isu ? ng - FF : ng; drow = dst + (size_t)((j >> 7) * 256 + isu * 128 + (j & 127)) * K; }
        else { drow = (ng < 3072) ? dst + (size_t)ng * K : dst2 + (size_t)(ng - 3072) * K; }
        *(u32x4*)(drow + kt * 64 + 8 * kc) = w;
    }
    __syncthreads();
}

__device__ __forceinline__ void mod_unit(LAS unsigned char* lds, const int tid, PP p, int l, int chunk, int kq, const int rep) {
    const int wave = tid >> 6, lane = tid & 63;
    LAS float* sc = (LAS float*)lds;
    LAS float* red = (LAS float*)(lds + 10240);
    for (int idx = tid; idx < 2560; idx += NTHR) { const int b = idx >> 9, k = idx & 511; const float cv = (b < 4) ? p->c[b * 2048 + kq * 512 + k] : p->c_ctx[kq * 512 + k];
        sc[idx] = cv / (1.0f + __expf(-cv)); }
    __syncthreads();
    const float* wp = p->w_mod + ((size_t)l * 2048 + kq * 512 + wave * 64) * NMODC + chunk * 256 + 4 * lane;
    f32x4 acc[5];
#pragma unroll
    for (int b = 0; b < 5; ++b) acc[b] = (f32x4){0.f, 0.f, 0.f, 0.f};
    for (int k0 = 0; k0 < 64; k0 += 8) {
        f32x4 w[8];
#pragma unroll
        for (int j = 0; j < 8; ++j) w[j] = __builtin_nontemporal_load((const f32x4*)(wp + (size_t)(k0 + j) * NMODC));
#pragma unroll
        for (int j = 0; j < 8; ++j)
#pragma unroll
            for (int b = 0; b < 5; ++b) acc[b] += w[j] * sc[b * 512 + wave * 64 + k0 + j];
    }
#pragma unroll
    for (int b = 0; b < 5; ++b) *(LAS f32x4*)(red + (wave * 5 + b) * 256 + 4 * lane) = acc[b];
    __syncthreads();
    float* mod = (float*)(p->ws + OFF_MOD) + (size_t)l * 5 * NMODC;
    for (int o = tid; o < 1280; o += NTHR) { const int b = o >> 8, cc = o & 255; float s = 0.f;
#pragma unroll
        for (int w = 0; w < 8; ++w) s += red[(w * 5 + b) * 256 + cc];
        if (kq == 0) s += p->b_mod[(size_t)l * NMODC + chunk * 256 + cc];
        if (rep == 0) atomicAdd(mod + (size_t)b * NMODC + chunk * 256 + cc, s); }
    __syncthreads();
}

__device__ __forceinline__ void wcs_unit(LAS unsigned char* lds, const int tid, PP p, int idx) {
    const int l = idx >> 3, g = (idx >> 1) & 3, cs = idx & 1;
    LAS float* tab = (LAS float*)lds;
    if (tid < 128) tab[tid] = (cs ? sinpif((float)tid * (1.0f / 64.0f)) : cospif((float)tid * (1.0f / 64.0f))) * 0.08838834764831845f;
    __syncthreads();
    const float* w4 = p->w_four + (size_t)(l * 4 + g) * 128 * 128;
    float* dst = (float*)(p->ws + OFF_WCS) + (size_t)((l * 4 + g) * 2 + cs) * 128 * 128;
    for (int o = tid; o < 128 * 128; o += NTHR) { const int cp = o >> 7, d = o & 127; float s = 0.f;
        for (int c = 0; c < 128; ++c) s += tab[(cp * c) & 127] * w4[c * 128 + d];
        dst[o] = s; }
    __syncthreads();
}
__device__ __forceinline__ void dft_unit(const int tid, PP p, int idx) {
    if (idx < 256) { bf16_t* dst = (bf16_t*)(p->ws + OFF_DFTL);
        for (int e = tid; e < 8 * 512; e += NTHR) { const int j = idx * 8 + (e >> 9), k8 = (e & 511) * 8; float v[8];
#pragma unroll
            for (int q = 0; q < 8; ++q) { const int k = k8 + q, kk = k & 2047, ph = (j * kk) & 2047; const float a = (float)ph * (1.0f / 1024.0f);
                v[q] = (k < 2048 ? cospif(a) : -sinpif(a)) * 0.022097086912079608f; }
            *(u32x4*)(dst + (size_t)j * 4096 + k8) = (u32x4){pk_bf16(v[0], v[1]), pk_bf16(v[2], v[3]), pk_bf16(v[4], v[5]), pk_bf16(v[6], v[7])}; }
    } else { bf16_t* dst = (bf16_t*)(p->ws + OFF_DFTC); const int r0 = (idx - 256) * 32;
        for (int e = tid; e < 32 * 64; e += NTHR) { const int j = r0 + (e >> 6), k8 = (e & 63) * 8; float v[8];
#pragma unroll
            for (int q = 0; q < 8; ++q) { const int k = k8 + q, kk = k & 255, ph = (j * kk) & 255; const float a = (float)ph * (1.0f / 128.0f);
                v[q] = (k < 256 ? cospif(a) : -sinpif(a)) * 0.0625f; }
            *(u32x4*)(dst + (size_t)j * 512 + k8) = (u32x4){pk_bf16(v[0], v[1]), pk_bf16(v[2], v[3]), pk_bf16(v[4], v[5]), pk_bf16(v[6], v[7])}; }
    }
}
__device__ __forceinline__ void fold_unit(LAS unsigned char* lds, const int tid, PP p, int idx) {
    const int l = idx >> 7, g = (idx >> 5) & 3, kt = idx & 31;
    LAS float* ws_ = (LAS float*)lds;
    const float* src = p->w_in + ((size_t)l * 2048 + kt * 64) * 5120 + 4608 + g * 128;
    for (int e = tid; e < 64 * 32; e += NTHR) { const int r = e >> 5, c4 = (e & 31) * 4; *(LAS f32x4*)(ws_ + r * 128 + c4) = *(const f32x4*)(src + (size_t)r * 5120 + c4); }
    __syncthreads();
    const int csd = tid & 255, kh = tid >> 8;
    const float* wcs = (const float*)(p->ws + OFF_WCS) + (size_t)((l * 4 + g) * 2 + (csd >> 7)) * 128 * 128 + (csd & 127);
    float acc[32];
#pragma unroll
    for (int j = 0; j < 32; ++j) acc[j] = 0.f;
    for (int c4 = 0; c4 < 128; c4 += 4) {
        const float w0 = wcs[(c4 + 0) * 128], w1 = wcs[(c4 + 1) * 128], w2 = wcs[(c4 + 2) * 128], w3 = wcs[(c4 + 3) * 128];
#pragma unroll
        for (int j = 0; j < 32; ++j) { const f32x4 v = *(const LAS f32x4*)(ws_ + (kh * 32 + j) * 128 + c4); acc[j] += v[0] * w0 + v[1] * w1 + v[2] * w2 + v[3] * w3; }
    }
    bf16_t* dst = (bf16_t*)(p->ws + OFF_W + (size_t)l * WSZ_LAYER + WO_VF) + (size_t)(1536 + g * 256 + csd) * D + kt * 64 + kh * 32;
#pragma unroll
    for (int j = 0; j < 4; ++j) *(u32x4*)(dst + 8 * j) = (u32x4){pk_bf16(acc[8 * j], acc[8 * j + 1]), pk_bf16(acc[8 * j + 2], acc[8 * j + 3]), pk_bf16(acc[8 * j + 4], acc[8 * j + 5]), pk_bf16(acc[8 * j + 6], acc[8 * j + 7])};
    __syncthreads();
}

constexpr int CV_WI1_0 = 0, CV_WO1_0 = 1408, CV_WIN_0 = 2112, CV_DFT = 2688, CV_WOUT_0 = 2952, CV_WI2_0 = 3208, CV_WO2_0 = 4616, CV_WI1_1 = 5320, CV_WO1_1 = 6728, CV_WIN_1 = 7432, CV_WOUT_1 = 8008,
              CV_WI2_1 = 8264, CV_WO2_1 = 9672, CV_END = 10376;
__device__ __forceinline__ void conv_unit(LAS unsigned char* lds, const int tid, PP p, int idx) {
    if (idx >= CV_DFT && idx < CV_WOUT_0) { dft_unit(tid, p, idx - CV_DFT); return; }
    const int l = idx >= CV_WI1_1;
    bf16_t* wl = (bf16_t*)(p->ws + OFF_W + (size_t)l * WSZ_LAYER);
    int i;
    if (l == 0) {
        if (idx < CV_WO1_0) { i = idx; transpose_unit(lds, tid, p->ffn1_wi, 2 * FF, D, i % 32, (i / 32 + i % 32) % 44, wl + WO_WI1 / 2, nullptr, 1); }
        else if (idx < CV_WIN_0) { i = idx - CV_WO1_0; transpose_unit(lds, tid, p->ffn1_wo, D, FF, i % 88, (i / 88 + i % 88) % 8, wl + WO_WO1 / 2, nullptr, 0); }
        else if (idx < CV_DFT) { i = idx - CV_WIN_0; transpose_unit(lds, tid, p->w_in, 5120, D, i % 32, (i / 32 + i % 32) % 18, wl + WO_QK / 2, wl + WO_VF / 2, 2); }
        else if (idx < CV_WI2_0) { i = idx - CV_WOUT_0; transpose_unit(lds, tid, p->w_out, D, D, i % 32, (i / 32 + i % 32) % 8, wl + WO_OUT / 2, nullptr, 0); }
        else if (idx < CV_WO2_0) { i = idx - CV_WI2_0; transpose_unit(lds, tid, p->ffn2_wi, 2 * FF, D, i % 32, (i / 32 + i % 32) % 44, wl + WO_WI2 / 2, nullptr, 1); }
        else { i = idx - CV_WO2_0; transpose_unit(lds, tid, p->ffn2_wo, D, FF, i % 88, (i / 88 + i % 88) % 8, wl + WO_WO2 / 2, nullptr, 0); }
    } else {
        if (idx < CV_WO1_1) { i = idx - CV_WI1_1; transpose_unit(lds, tid, p->ffn1_wi + (size_t)D * 2 * FF, 2 * FF, D, i % 32, (i / 32 + i % 32) % 44, wl + WO_WI1 / 2, nullptr, 1); }
        else if (idx < CV_WIN_1) { i = idx - CV_WO1_1; transpose_unit(lds, tid, p->ffn1_wo + (size_t)FF * D, D, FF, i % 88, (i / 88 + i % 88) % 8, wl + WO_WO1 / 2, nullptr, 0); }
        else if (idx < CV_WOUT_1) { i = idx - CV_WIN_1; transpose_unit(lds, tid, p->w_in + (size_t)D * 5120, 5120, D, i % 32, (i / 32 + i % 32) % 18, wl + WO_QK / 2, wl + WO_VF / 2, 2); }
        else if (idx < CV_WI2_1) { i = idx - CV_WOUT_1; transpose_unit(lds, tid, p->w_out + (size_t)D * D, D, D, i % 32, (i / 32 + i % 32) % 8, wl + WO_OUT / 2, nullptr, 0); }
        else if (idx < CV_WO2_1) { i = idx - CV_WI2_1; transpose_unit(lds, tid, p->ffn2_wi + (size_t)D * 2 * FF, 2 * FF, D, i % 32, (i / 32 + i % 32) % 44, wl + WO_WI2 / 2, nullptr, 1); }
        else { i = idx - CV_WO2_1; transpose_unit(lds, tid, p->ffn2_wo + (size_t)FF * D, D, FF, i % 88, (i / 88 + i % 88) % 8, wl + WO_WO2 / 2, nullptr, 0); }
    }
}
__device__ __forceinline__ void conv_range(LAS unsigned char* lds, const int tid, PP p, int lo, int hi, int rank, int nb) { for (int i = lo + rank; i < hi; i += nb) conv_unit(lds, tid, p, i); }

constexpr int P0_MOD = 576, P0_WCS = 16;
__device__ __forceinline__ void prep_phase(LAS unsigned char* lds, const int tid, const int bx, PP p, const int rep) {
    for (int it = bx; it < P0_MOD + P0_WCS + CV_WO1_0; it += gridDim.x) {
        int i = it;
        if (i < P0_MOD) { const int l = i / 288, rem = i % 288; mod_unit(lds, tid, p, l, rem >> 2, rem & 3, rep); continue; }
        i -= P0_MOD;
        if (i < P0_WCS) { wcs_unit(lds, tid, p, i); continue; }
        i -= P0_WCS;
        conv_unit(lds, tid, p, i);
    }
}

constexpr size_t PPLANE = (size_t)32 * 65536;
__device__ __forceinline__ void norm_phase(const int tid, const int bx, unsigned char* ws, const float* xlat, const float* xctx, int nrows, const float* nw, const float* modl, int jshift,
                                           float* Xout, const float* P, const float* pgate, float pgs) {
    const int wave = tid >> 6, lane = tid & 63;
    bf16_t* A = (bf16_t*)(ws + OFF_A);
    for (int row = bx * 8 + wave; row < nrows; row += gridDim.x * 8) {
        const float* src = (row < TL ? xlat : xctx) + (size_t)row * D;
        const int b = row < TL ? (row >> 11) : 4;
        f32x4 v[8]; float ss = 0.f;
#pragma unroll
        for (int i = 0; i < 8; ++i) v[i] = *(const f32x4*)(src + 4 * (lane + 64 * i));
        if (P && row >= TL) {
            const int rr = row - TL; const float* pp = P + (size_t)((rr >> 8) * 8) * 65536 + (rr & 255) * 256 + 4 * lane;
#pragma unroll
            for (int i = 0; i < 8; ++i) { f32x4 a = (f32x4){0.f, 0.f, 0.f, 0.f};
#pragma unroll
                for (int ks = 0; ks < 8; ++ks) a += *(const f32x4*)(pp + (size_t)ks * PPLANE + (size_t)i * 65536);
                v[i] += a * (*(const f32x4*)(pgate + 4 * (lane + 64 * i)) * pgs); }
        }
        if (Xout && (P == nullptr || row >= TL)) {
#pragma unroll
            for (int i = 0; i < 8; ++i) *(f32x4*)(Xout + (size_t)row * D + 4 * (lane + 64 * i)) = v[i];
        }
#pragma unroll
        for (int i = 0; i < 8; ++i) ss += v[i][0] * v[i][0] + v[i][1] * v[i][1] + v[i][2] * v[i][2] + v[i][3] * v[i][3];
#pragma unroll
        for (int o = 32; o >= 1; o >>= 1) ss += __shfl_xor(ss, o);
        const float rstd = rsqrtf(ss * (1.0f / 2048.0f) + 1e-6f);
        const float* sh = modl + (size_t)b * NMODC + jshift * 2048; const float* scp = sh + 2048;
#pragma unroll
        for (int i = 0; i < 8; ++i) { const int col = 4 * (lane + 64 * i);
            const f32x4 w = *(const f32x4*)(nw + col), s1 = *(const f32x4*)(scp + col), s0 = *(const f32x4*)(sh + col);
            const f32x4 y = (v[i] * rstd * w) * (s1 + 1.0f) + s0;
            *(u32x2*)(A + (size_t)row * D + col) = (u32x2){pk_bf16(y[0], y[1]), pk_bf16(y[2], y[3])}; }
    }
}

typedef __bf16 bf2_t __attribute__((ext_vector_type(2)));
__device__ __forceinline__ float sumsq8(const u32x4& w, float s) {
#pragma unroll
    for (int i = 0; i < 4; ++i) { const float a = bf_lo(w[i]), b = bf_hi(w[i]); s = fmaf(a, a, s); s = fmaf(b, b, s); } return s; }

constexpr int AT_KP = 272, AT_VP = 144;
constexpr int AT_K = 0, AT_V = AT_K + 2 * 64 * AT_KP, AT_RK = AT_V + 2 * 128 * AT_VP, AT_BIAS = AT_RK + 512, AT_END = AT_BIAS + 2 * 480 * 4;
struct AtStage { u32x4 k[4], v[4]; };
__device__ __forceinline__ void at_load(AtStage& st, const bf16_t* QK, const bf16_t* VtL, const bf16_t* VtC, int c, int nwin, int b, int hp, int rs, int tid) {
    const int hs = hp * 2 + (tid >> 8), t8 = tid & 255;
    const bool win = c < nwin;
    const int ktok0 = win ? (b * 2048 + (rs + c) * 64) : (TL + b * 256 + 64 * (c - nwin));
    const bf16_t* kp = QK + (size_t)(ktok0 + (t8 >> 4)) * 3072 + 1536 + hs * 128 + 8 * (t8 & 15);
#pragma unroll
    for (int j = 0; j < 4; ++j) st.k[j] = *(const u32x4*)(kp + (size_t)(16 * j) * 3072);
    const bf16_t* vsrc = win ? (VtL + (size_t)(b * 1536 + hs * 128) * 2048 + (rs + c) * 64) : (VtC + (size_t)(b * 1536 + hs * 128) * 256 + 64 * (c - nwin));
    const int vpitch = win ? 2048 : 256;
    const bf16_t* vp = vsrc + (size_t)(t8 >> 3) * vpitch + 8 * (t8 & 7);
#pragma unroll
    for (int j = 0; j < 4; ++j) st.v[j] = *(const u32x4*)(vp + (size_t)(32 * j) * vpitch);
}
__device__ __forceinline__ void at_store(const AtStage& st, LAS unsigned char* lds, int tid) {
    const int sh = tid >> 8, t8 = tid & 255;
#pragma unroll
    for (int j = 0; j < 4; ++j) { const int row = (t8 >> 4) + 16 * j;
        float ss = sumsq8(st.k[j], 0.f); ss += __shfl_xor(ss, 1); ss += __shfl_xor(ss, 2); ss += __shfl_xor(ss, 4); ss += __shfl_xor(ss, 8);
        if ((t8 & 15) == 0) *(LAS float*)(lds + AT_RK + (sh * 64 + row) * 4) = rsqrtf(ss * (1.0f / 128.0f) + 1e-6f);
        *(LAS u32x4*)(lds + AT_K + (sh * 64 + row) * AT_KP + 16 * (t8 & 15)) = st.k[j]; }
#pragma unroll
    for (int j = 0; j < 4; ++j) *(LAS u32x4*)(lds + AT_V + (sh * 128 + (t8 >> 3) + 32 * j) * AT_VP + 16 * (t8 & 7)) = st.v[j];
}

__device__ __forceinline__ void attn_block(LAS unsigned char* lds, const int tid, const bf16_t* QK, const bf16_t* VtL, const bf16_t* VtC, bf16_t* CAT, const float* gq, const float* gk, const float* rpbl,
                                           int b, int hp, int r, int qg, bool ctxq) {
    const int lane = tid & 63, wave = tid >> 6, fr = lane & 15, fq = lane >> 4, hh = wave >> 2, qt = wave & 3, h = hp * 2 + hh;
    const int qtok = ctxq ? (TL + b * 256 + qg * 64 + qt * 16 + fr) : (b * 2048 + r * 64 + qt * 16 + fr);
    const int nwin = ctxq ? 0 : 8, nchunks = nwin + 4;
    const int rs = min(max(r - 4, 0), 24);
    AtStage st;
    at_load(st, QK, VtL, VtC, 0, nwin, b, hp, rs, tid);
    bf16x8 qf[4];
    {
        const u32x4* qp = (const u32x4*)(QK + (size_t)qtok * 3072 + h * 128 + 8 * fq);
        u32x4 qr[4]; float ss = 0.f;
#pragma unroll
        for (int ks = 0; ks < 4; ++ks) { qr[ks] = qp[4 * ks]; ss = sumsq8(qr[ks], ss); }
        ss += __shfl_xor(ss, 16); ss += __shfl_xor(ss, 32);
        const float rq = rsqrtf(ss * (1.0f / 128.0f) + 1e-6f) * (0.08838834764831845f * LOG2E);
#pragma unroll
        for (int ks = 0; ks < 4; ++ks) { const int d0 = 32 * ks + 8 * fq;
            const f32x4 ga = *(const f32x4*)(gq + d0) * *(const f32x4*)(gk + d0), gb = *(const f32x4*)(gq + d0 + 4) * *(const f32x4*)(gk + d0 + 4);
            u32x4 w; w.x = pk_bf16(bf_lo(qr[ks].x) * rq * ga[0], bf_hi(qr[ks].x) * rq * ga[1]); w.y = pk_bf16(bf_lo(qr[ks].y) * rq * ga[2], bf_hi(qr[ks].y) * rq * ga[3]);
            w.z = pk_bf16(bf_lo(qr[ks].z) * rq * gb[0], bf_hi(qr[ks].z) * rq * gb[1]); w.w = pk_bf16(bf_lo(qr[ks].w) * rq * gb[2], bf_hi(qr[ks].w) * rq * gb[3]);
            qf[ks] = __builtin_bit_cast(bf16x8, w); }
    }
    __syncthreads();
    if (!ctxq) for (int e = tid; e < 2 * 465; e += NTHR) { const int sh = e >= 465, i = e - sh * 465; *(LAS float*)(lds + AT_BIAS + (sh * 480 + i) * 4) = rpbl[(size_t)(hp * 2 + sh) * 465 + i] * LOG2E; }
    at_store(st, lds, tid);
    __syncthreads();
    const int s0 = (qt == 0) ? 0 : (qt == 1) ? 8 : (qt == 2) ? 24 : 32;
    const int cq = 16 * qt + fr, cs = min(max(cq - 8, 0), 48);
    const int lo = cs - (s0 + 8 * fq);
    unsigned vmask = (lo >= 0) ? (0xFFFFu << min(lo, 31)) : (0xFFFFu >> min(-lo, 31));
    asm volatile("" : "+v"(vmask));
    float m_run = -INFINITY, l_run = 0.f;
    f32x4 O[8];
#pragma unroll
    for (int dt = 0; dt < 8; ++dt) O[dt] = (f32x4){0.f, 0.f, 0.f, 0.f};
    const int krow = 8 * (fr >> 2) + (fr & 3);
    for (int c = 0; c < nchunks; ++c) {
        const bool win = c < nwin;
        if (c + 1 < nchunks) at_load(st, QK, VtL, VtC, c + 1, nwin, b, hp, rs, tid);
        const int nsub = win ? 1 : 2;
        for (int sub = 0; sub < nsub; ++sub) {
            const int koff = win ? s0 : 32 * sub;
            const LAS unsigned char* kl = lds + AT_K + (hh * 64 + koff + krow) * AT_KP + 16 * fq;
            u32x4 k0[4], k1[4], vv[8];
#pragma unroll
            for (int ks = 0; ks < 4; ++ks) { k0[ks] = *(const LAS u32x4*)(kl + 64 * ks); k1[ks] = *(const LAS u32x4*)(kl + 4 * AT_KP + 64 * ks); }
            const f32x4 rka = *(const LAS f32x4*)(lds + AT_RK + (hh * 64 + koff + 8 * fq) * 4), rkb = *(const LAS f32x4*)(lds + AT_RK + (hh * 64 + koff + 8 * fq + 4) * 4);
            const LAS unsigned char* vl = lds + AT_V + (hh * 128 + fr) * AT_VP + (koff + 8 * fq) * 2;
#pragma unroll
            for (int dt = 0; dt < 8; ++dt) vv[dt] = *(const LAS u32x4*)(vl + 16 * dt * AT_VP);
            f32x4 sa = (f32x4){0.f, 0.f, 0.f, 0.f}, sb = (f32x4){0.f, 0.f, 0.f, 0.f};
#pragma unroll
            for (int ks = 0; ks < 4; ++ks) { sa = __builtin_amdgcn_mfma_f32_16x16x32_bf16(__builtin_bit_cast(bf16x8, k0[ks]), qf[ks], sa, 0, 0, 0);
                sb = __builtin_amdgcn_mfma_f32_16x16x32_bf16(__builtin_bit_cast(bf16x8, k1[ks]), qf[ks], sb, 0, 0, 0); }
            float s[8];
#pragma unroll
            for (int t = 0; t < 4; ++t) { s[t] = sa[t] * rka[t]; s[4 + t] = sb[t] * rkb[t]; }
            if (win) {
                const LAS float* brow = (const LAS float*)(lds + AT_BIAS) + hh * 480 + (rs + c - r + 7) * 31 + 15 + (s0 + 8 * fq - cq);
#pragma unroll
                for (int e = 0; e < 8; ++e) { const int dcl = min(max(s0 + 8 * fq + e - cq, -15), 15) - (s0 + 8 * fq - cq); s[e] = ((vmask >> e) & 1u) ? s[e] + brow[dcl] : -INFINITY; }
            }
            float cm = fmaxf(fmaxf(fmaxf(s[0], s[1]), fmaxf(s[2], s[3])), fmaxf(fmaxf(s[4], s[5]), fmaxf(s[6], s[7])));
            cm = fmaxf(cm, __shfl_xor(cm, 16)); cm = fmaxf(cm, __shfl_xor(cm, 32));
            const float mn = fmaxf(m_run, cm), alpha = __builtin_amdgcn_exp2f(m_run - mn);
            float ps = 0.f;
#pragma unroll
            for (int e = 0; e < 8; ++e) { s[e] = __builtin_amdgcn_exp2f(s[e] - mn); ps += s[e]; }
            l_run = l_run * alpha + ps; m_run = mn;
            const u32x4 pw = (u32x4){pk_bf16(s[0], s[1]), pk_bf16(s[2], s[3]), pk_bf16(s[4], s[5]), pk_bf16(s[6], s[7])};
            const bf16x8 pf = __builtin_bit_cast(bf16x8, pw);
#pragma unroll
            for (int dt = 0; dt < 8; ++dt) { O[dt] *= alpha; O[dt] = __builtin_amdgcn_mfma_f32_16x16x32_bf16(__builtin_bit_cast(bf16x8, vv[dt]), pf, O[dt], 0, 0, 0); }
        }
        if (c + 1 < nchunks) { __syncthreads(); at_store(st, lds, tid); __syncthreads(); }
    }
    l_run += __shfl_xor(l_run, 16); l_run += __shfl_xor(l_run, 32);
    const float inv = 1.0f / l_run;
    bf16_t* op = CAT + (size_t)qtok * D + h * 128 + 4 * fq;
#pragma unroll
    for (int dt = 0; dt < 8; ++dt) *(u32x2*)(op + 16 * dt) = (u32x2){pk_bf16(O[dt][0] * inv, O[dt][1] * inv), pk_bf16(O[dt][2] * inv, O[dt][3] * inv)};
}

#define XB_TMO      128
#define XB_XCNT(j)  (256  + 64 * (j))
#define XB_XSUB(j)  (1280 + 64 * (j))
#define XB_XGEN(j)  (2304 + 64 * (j))
#define XB_TOP      3328
#define XB_TOPGEN   3392
#define XCD_BAR_WORDS 3456
#define XB_SPIN_CAP (1u << 20)
__device__ __forceinline__ unsigned xb_ld(unsigned* p)              { return __hip_atomic_load(p, __ATOMIC_RELAXED, __HIP_MEMORY_SCOPE_AGENT); }
__device__ __forceinline__ unsigned xb_add(unsigned* p, unsigned v) { return __hip_atomic_fetch_add(p, v, __ATOMIC_RELAXED, __HIP_MEMORY_SCOPE_AGENT); }
__device__ __forceinline__ unsigned xb_xcc_id() { return (unsigned)__builtin_amdgcn_s_getreg((3 << 11) | 20) & 0xFu; }
#define XB_SPIN(cond, bar) do { unsigned _sp = 0; while (cond) { __builtin_amdgcn_s_sleep(1); \
    if ((++_sp & 255u) == 0u) { if (xb_ld(&(bar)[XB_TMO])) break; if (_sp > XB_SPIN_CAP) { atomicAdd(&(bar)[XB_TMO], 1u); break; } } } } while (0)
struct XcdBarrier { unsigned* bar; unsigned x; volatile LAS unsigned* st; };
__device__ __forceinline__ XcdBarrier xcd_barrier_post(unsigned* bar, volatile LAS unsigned* st) {
    XcdBarrier b; b.bar = bar; b.x = xb_xcc_id(); b.st = st;
    if (threadIdx.x == 0) (void)xb_add(&bar[XB_XCNT(b.x)], 1u);
    return b;
}
__device__ __forceinline__ void xcd_barrier_complete(unsigned* bar, unsigned x, unsigned& nloc, unsigned& nx) {
    const unsigned G = gridDim.x * gridDim.y * gridDim.z;
    unsigned sum, cnt, mine, sp = 0u;
    for (;;) {
        sum = 0u; cnt = 0u; mine = 0u;
#pragma unroll
        for (unsigned j = 0; j < 16; ++j) { const unsigned c = xb_ld(&bar[XB_XCNT(j)]); sum += c; cnt += (c > 0u) ? 1u : 0u; mine = (j == x) ? c : mine; }
        if (sum == G) break;
        __builtin_amdgcn_s_sleep(1);
        if ((++sp & 255u) == 0u) { if (xb_ld(&bar[XB_TMO])) break; if (sp > XB_SPIN_CAP) { atomicAdd(&bar[XB_TMO], 1u); break; } }
    }
    nloc = mine > 0u ? mine : 1u; nx = cnt > 0u ? cnt : 1u;
}
__device__ __forceinline__ void xcd_barrier(const XcdBarrier& b) {
    asm volatile("s_waitcnt vmcnt(0)" ::: "memory");
    __syncthreads();
    if (threadIdx.x == 0) {
        unsigned* bar = b.bar;
        __builtin_amdgcn_s_waitcnt(0);
        unsigned nloc = b.st[0], nx = b.st[1];
        if (nloc == 0u) { xcd_barrier_complete(bar, b.x, nloc, nx); b.st[0] = nloc; b.st[1] = nx; }
        const unsigned old = xb_add(&bar[XB_XSUB(b.x)], 1u);
        const unsigned gen = old / nloc;
        if (old + 1u == (gen + 1u) * nloc) {
            __builtin_amdgcn_fence(__ATOMIC_RELEASE, "agent");
            asm volatile("s_waitcnt vmcnt(0)" ::: "memory");
            const unsigned og = xb_add(&bar[XB_TOP], 1u);
            const unsigned tg = og / nx;
            if (og + 1u == (tg + 1u) * nx) xb_add(&bar[XB_TOPGEN], 1u);
            else XB_SPIN(xb_ld(&bar[XB_TOPGEN]) == tg, bar);
            __builtin_amdgcn_fence(__ATOMIC_ACQUIRE, "agent");
            xb_add(&bar[XB_XGEN(b.x)], 1u);
            asm volatile("s_waitcnt vmcnt(0)" ::: "memory");
        } else {
            XB_SPIN(xb_ld(&bar[XB_XGEN(b.x)]) == gen, bar);
            __builtin_amdgcn_fence(__ATOMIC_ACQUIRE, "agent");
            asm volatile("s_waitcnt vmcnt(0)" ::: "memory");
        }
    }
    __syncthreads();
}

__global__ void __launch_bounds__(NTHR, 2) fwd_megakernel(Params p_unused) {
    extern __shared__ __attribute__((aligned(16))) unsigned char lds_raw[];
    LAS unsigned char* lds = (LAS unsigned char*)lds_raw;
    cg::grid_group grid = cg::this_grid();
    const int G = gridDim.x;
    const int ph_lo = p_unused.ph_lo, ph_hi = p_unused.ph_hi;
    if (threadIdx.x < 16) ((LAS unsigned*)(lds + LDS_STAGE))[threadIdx.x] = 0u;
    __syncthreads();
    (void)xcd_barrier_post((unsigned*)(p_unused.ws + OFF_BAR), (volatile LAS unsigned*)(lds + LDS_STAGE));
    for (int ph = ph_lo; ph < ph_hi; ++ph)
    for (int rep = 0; rep < ((ph == REP_PH) ? 1 + REP_N : 1); ++rep) {
        if (ph > ph_lo || rep > 0) for (int sr = 0; sr < SYNC_REP; ++sr) { if (ph_hi > 1000) grid.sync();
            else {
            XcdBarrier xb; unsigned char* wsb = p_unused.ws; asm volatile("" : "+s"(wsb));
            xb.bar = (unsigned*)(wsb + OFF_BAR); xb.x = xb_xcc_id(); xb.st = (volatile LAS unsigned*)(lds + LDS_STAGE); xcd_barrier(xb); } }
        PP p = (PP)__builtin_amdgcn_kernarg_segment_ptr(); asm volatile("" : "+s"(p));
        int tid = threadIdx.x, bx = blockIdx.x; unsigned char* ws = p->ws;
        asm volatile("" : "+v"(tid)); asm volatile("" : "+s"(bx)); asm volatile("" : "+s"(ws));
        const int wave = tid >> 6, lane = tid & 63;
    float* X = (float*)(ws + OFF_X); bf16_t* A = (bf16_t*)(ws + OFF_A); bf16_t* H = (bf16_t*)(ws + OFF_H); bf16_t* QK = (bf16_t*)(ws + OFF_QK);
    bf16_t* VtL = (bf16_t*)(ws + OFF_VTL); bf16_t* VtC = (bf16_t*)(ws + OFF_VTC); bf16_t* UtL = (bf16_t*)(ws + OFF_UTL); bf16_t* UtC = (bf16_t*)(ws + OFF_UTC);
    bf16_t* CAT = (bf16_t*)(ws + OFF_CAT); const bf16_t* DFTL = (const bf16_t*)(ws + OFF_DFTL); const bf16_t* DFTC = (const bf16_t*)(ws + OFF_DFTC);
    const float* MOD = (const float*)(ws + OFF_MOD);

        if (ph == 0) { prep_phase(lds, tid, bx, p, rep); continue; }
        const int l = (ph - 1) / 10, sp = (ph - 1) % 10; const bool last = (l == 1);
        const float* modl = MOD + (size_t)l * 5 * NMODC;
        const unsigned char* wl = ws + OFF_W + (size_t)l * WSZ_LAYER;
        if (sp == 0 || sp == 3 || sp == 7) {
            if (ph == 1) for (int it = bx; it < 256; it += G) fold_unit(lds, tid, p, it);
            const bool first = (ph == 1);
            const int nrows = (last && sp == 7) ? TL : T;
            const bool pend = !first && !(last && sp == 7);
            const float* pgate = (sp == 0) ? MOD + 4 * NMODC + 8 * 2048 : modl + 4 * NMODC + (sp == 3 ? 2 : 5) * 2048;
            for (int nrep = 0; nrep < NORM_REP; ++nrep)
            norm_phase(tid, bx, ws, first ? p->x : X, first ? p->ctx - (size_t)TL * D : X, nrows, p->norm_w + (size_t)(l * 3 + (sp == 0 ? 0 : sp == 3 ? 1 : 2)) * D, modl, sp == 0 ? 0 : sp == 3 ? 3 : 6,
                       (nrep == 0 && (first || pend)) ? X : nullptr, (nrep == 0 && pend) ? (const float*)(ws + OFF_PART) : nullptr, pgate, sp == 7 ? 1.0f : 0.5f);
        } else if (sp == 1 || sp == 8) {
            const int nM = (last && sp == 8) ? 32 : 36;
            const pg8::MSched S = pg8::sched1(A, (const bf16_t*)(wl + (sp == 1 ? WO_WI1 : WO_WI2)), nM, 44, 0, G, bx, (size_t)256 * D * 2);
            pg8::EpiSwiglu E{H};
            pg8::gemm_phase(lds, tid, D, D, S, E);
            if (sp == 1 && !last) { if (bx >= 48) conv_range(lds, tid, p, CV_WO1_0, CV_WI2_0, bx - 48, G - 48); }
            else if (sp == 8 && !last) { if (bx >= 48) conv_range(lds, tid, p, 5936, 7808, bx - 48, G - 48); }
            else if (sp == 1 && last) { if (bx >= 48) conv_range(lds, tid, p, 7808, CV_WO2_1, bx - 48, G - 48); }
            else { if (bx >= 128) conv_range(lds, tid, p, 10312, CV_END, bx - 128, G - 128); }
        } else if (sp == 2 || sp == 9 || sp == 6) {
            const bool fin = last && sp == 9; const bool hasctx = !(last && sp != 2);
            const bf16_t* Am = (sp == 6) ? CAT : H; const int K = (sp == 6) ? D : FF;
            const bf16_t* Bm = (const bf16_t*)(wl + (sp == 2 ? WO_WO1 : sp == 9 ? WO_WO2 : WO_OUT));
            float* dummy = (float*)(ws + OFF_DUMMY);
            const bool tail_first = false;
            for (int step = 0; step < 2; ++step) {
                if ((step == 0) != tail_first) {
                    const pg8::MSched S = pg8::sched1(Am, Bm, 32, 8, 0, G, bx, (size_t)256 * K * 2);
                    pg8::EpiRes E{X, rep ? dummy : fin ? p->out : X, rep ? dummy : X, modl + (sp == 2 ? 2 : sp == 6 ? 5 : 8) * 2048, sp == 6 ? 1.0f : 0.5f, nullptr};
                    pg8::gemm_phase(lds, tid, K, K, S, E);
                } else if (hasctx) {
                    for (int su = bx; su < 256; su += G) {
                        const int ks = su & 7, tile = su >> 3;
                        const int np = (sp == 6) ? 2 : (ks < 4 ? 6 : 5), p0 = (sp == 6) ? 2 * ks : (ks < 4 ? 6 * ks : 24 + 5 * (ks - 4));
                        pg8::MSched S = pg8::sched1(Am, Bm, 36, 8, 0, 1 << 20, 0, (size_t)256 * K * 2);
                        S.pk0 = S.pk1 = S.pk2 = S.pk3 = pg8::mkpk(32 + (tile >> 3), 1, tile & 7, 1, 0); S.total = 1; S.koff = (size_t)p0 * 256;
                        pg8::EpiRes E{X, dummy, dummy, modl, 0.f, (float*)(ws + OFF_PART) + (size_t)ks * PPLANE};
                        pg8::gemm_phase(lds, tid, np * 128, K, S, E);
                    }
                }
            }
        } else if (sp == 4) {
            const bf16_t* Wqk = (const bf16_t*)(wl + WO_QK); const bf16_t* Wvf = (const bf16_t*)(wl + WO_VF);
            pg8::MSched S; S.G = G; S.c = bx; S.tstep = (size_t)256 * D * 2; S.koff = 0;
            S.A0 = A; S.B0 = Wqk; S.A1 = Wvf; S.B1 = A; S.A2 = A; S.B2 = Wqk; S.A3 = Wvf; S.B3 = A;
            S.pk0 = pg8::mkpk(0, last ? 32 : 36, 0, 12, 0); S.pk1 = pg8::mkpk(0, 10, 0, last ? 32 : 36, 1); S.pk2 = pg8::mkpk(32, 4, 6, 6, 0); S.pk3 = pg8::mkpk(0, 6, 32, 4, 1);
            S.st1 = last ? 384 : 432; S.st2 = last ? 704 : 0x7fffffff; S.st3 = last ? 728 : 0x7fffffff; S.total = last ? 752 : 792;
            pg8::EpiWin E{ws};
            pg8::gemm_phase(lds, tid, D, D, S, E);
            if (!last && bx >= 24) conv_range(lds, tid, p, CV_WI2_0, 5296, bx - 24, G - 24);
        } else {
            for (int drep = 0; drep < DFT_REP; ++drep)
            if (bx < 64 || (!last && bx < 72)) {
                const bool dl = bx < 64; const int K = dl ? 4096 : 512;
                const pg8::MSched S = pg8::sched1(dl ? DFTL : DFTC, dl ? UtL : UtC, dl ? 8 : 1, 8, dl ? 0 : 1, dl ? 64 : 8, dl ? bx : bx - 64, (size_t)256 * K * 2);
                pg8::EpiDft E{CAT};
#ifndef NO_G4
                pg8::gemm_phase(lds, tid, K, K, S, E);
#endif
            }
            if (bx < 64) { if (!last) conv_range(lds, tid, p, 5296, 5936, bx, 64); else conv_range(lds, tid, p, CV_WO2_1, 10312, bx, 64); }
            for (int arep = 0; arep < ATT_REP; ++arep)
            if (bx >= 64) {
                const int nitems = last ? 768 : 768 + 96;
                const float* gq = p->q_norm_w + l * 128; const float* gk = p->k_norm_w + l * 128; const float* rpbl = p->rpb + (size_t)l * 12 * 465;
                for (int it = bx - 64; it < nitems; it += G - 64) {
                    if (it < 768) {
                        const int a = it % 192, x = a & 7, j = a >> 3, hp = 3 * (x & 1) + j % 3, r = 8 * (x >> 1) + j / 3;
                        attn_block(lds, tid, QK, VtL, VtC, CAT, gq, gk, rpbl, it / 192, hp, r, 0, false); }
                    else { const int j = it - 768, hp = j % 6, qg = (j / 6) & 3, b = j / 24; attn_block(lds, tid, QK, VtL, VtC, CAT, gq, gk, rpbl, b, hp, 0, qg, true); }
                }
            }
        }
    }
}

extern "C" void kernel_launch(void* const* d_in, const int* in_sizes, int n_in, void* d_out, int out_size, void* d_ws, size_t ws_size, hipStream_t stream) {
    static int grid_blocks = 0;
    if (!grid_blocks) {
        int dev = 0, cus = 0, per_cu = 0;
        hipGetDevice(&dev);
        hipDeviceGetAttribute(&cus, hipDeviceAttributeMultiprocessorCount, dev);
        hipFuncSetAttribute((const void*)fwd_megakernel, hipFuncAttributeMaxDynamicSharedMemorySize, LDS_BYTES);
        hipOccupancyMaxActiveBlocksPerMultiprocessor(&per_cu, (const void*)fwd_megakernel, NTHR, LDS_BYTES);
        if (per_cu < 1) { fprintf(stderr, "occupancy query says %d blocks/CU\n", per_cu); per_cu = 1; }
        grid_blocks = cus * 1;
        if (ws_size < WS_END) fprintf(stderr, "workspace too small: %zu < %zu\n", ws_size, (size_t)WS_END);
    }
    Params p{};
    p.x = (const float*)d_in[0]; p.c = (const float*)d_in[1]; p.ctx = (const float*)d_in[2]; p.c_ctx = (const float*)d_in[3]; p.w_mod = (const float*)d_in[4]; p.b_mod = (const float*)d_in[5];
    p.norm_w = (const float*)d_in[6]; p.ffn1_wi = (const float*)d_in[7]; p.ffn1_wo = (const float*)d_in[8]; p.w_in = (const float*)d_in[9]; p.q_norm_w = (const float*)d_in[10];
    p.k_norm_w = (const float*)d_in[11]; p.rpb = (const float*)d_in[12]; p.w_four = (const float*)d_in[13]; p.w_out = (const float*)d_in[14]; p.ffn2_wi = (const float*)d_in[15]; p.ffn2_wo = (const float*)d_in[16];
    p.out = (float*)d_out; p.ws = (unsigned char*)d_ws;
    (void)hipMemsetAsync((char*)d_ws + OFF_BAR, 0, SZ_BAR + SZ_MOD, stream);
#if MULTI_LAUNCH
    for (int ph = 0; ph < 21; ++ph) { p.ph_lo = ph; p.ph_hi = ph + 1; hipLaunchKernelGGL(fwd_megakernel, dim3(grid_blocks), dim3(NTHR), LDS_BYTES, stream, p); }
#else
    p.ph_lo = 0; p.ph_hi = 21;
    void* args[] = {&p};
    hipError_t e = hipLaunchCooperativeKernel((const void*)fwd_megakernel, dim3(grid_blocks), dim3(NTHR), args, LDS_BYTES, stream);
    if (e != hipSuccess) fprintf(stderr, "cooperative launch failed: %s (grid %d)\n", hipGetErrorString(e), grid_blocks);
#endif
}
```

```cpp
#include <hip/hip_runtime.h>
#include <hip/hip_cooperative_groups.h>
#include <cstdio>
namespace cg = cooperative_groups;

#define LAS __attribute__((address_space(3)))
#define GAS __attribute__((address_space(1)))
typedef unsigned short bf16_t;
typedef short bf16x8 __attribute__((ext_vector_type(8)));
typedef float f32x4 __attribute__((ext_vector_type(4)));
typedef float f32x2 __attribute__((ext_vector_type(2)));
typedef unsigned u32x4 __attribute__((ext_vector_type(4)));
typedef unsigned u32x2 __attribute__((ext_vector_type(2)));

#ifndef MULTI_LAUNCH
#define MULTI_LAUNCH 0
#endif
#ifndef REP_PH
#define REP_PH (-1)
#endif
#ifndef REP_N
#define REP_N 0
#endif
#define ATT_REP 1
#define DFT_REP 1
#define SYNC_REP 1
#define TAIL_REP 1
#define MAIN_REP 1
#define NORM_REP 1

constexpr int D = 2048, TL = 8192, TC = 1024, T = TL + TC, FF = 5632, NMODC = 9 * 2048;
constexpr int NTHR = 512;
constexpr int LDS_STAGE = 131072;
constexpr int LDS_XB = 148224;
constexpr int LDS_BYTES = LDS_XB + 64;
constexpr float LOG2E = 1.4426950408889634f;

constexpr size_t SZ_MOD = (size_t)2 * 5 * NMODC * 4;
constexpr size_t OFF_BAR = 0;
constexpr size_t SZ_BAR = 16384;
constexpr size_t OFF_MOD = OFF_BAR + SZ_BAR;
constexpr size_t OFF_KSS = OFF_MOD + SZ_MOD;
constexpr size_t SZ_KSS = (size_t)2 * T * 12 * 4;
constexpr size_t OFF_WCS = OFF_KSS + SZ_KSS;
constexpr size_t OFF_X = OFF_WCS + (size_t)2 * 4 * 2 * 128 * 128 * 4;
constexpr size_t OFF_A = OFF_X + (size_t)T * D * 4;
constexpr size_t OFF_H = OFF_A + (size_t)T * D * 2;
constexpr size_t OFF_QK = OFF_H + (size_t)T * FF * 2;
constexpr size_t OFF_VTL = OFF_QK + (size_t)T * 3072 * 2;
constexpr size_t OFF_VTC = OFF_VTL + (size_t)4 * 1536 * 2048 * 2;
constexpr size_t OFF_UTL = OFF_VTC + (size_t)4 * 1536 * 256 * 2;
constexpr size_t OFF_UTC = OFF_UTL + (size_t)2048 * 4096 * 2;
constexpr size_t OFF_CAT = OFF_UTC + (size_t)2048 * 512 * 2;
constexpr size_t OFF_DFTL = OFF_CAT + (size_t)T * D * 2;
constexpr size_t OFF_DFTC = OFF_DFTL + (size_t)2048 * 4096 * 2;
constexpr size_t OFF_W = OFF_DFTC + (size_t)256 * 512 * 2;
constexpr size_t WSZ_WI = (size_t)2 * FF * D * 2, WSZ_WO = (size_t)D * FF * 2, WSZ_QK = (size_t)3072 * D * 2, WSZ_VF = (size_t)2560 * D * 2, WSZ_OUT = (size_t)D * D * 2;
constexpr size_t WO_WI1 = 0, WO_WO1 = WO_WI1 + WSZ_WI, WO_QK = WO_WO1 + WSZ_WO, WO_VF = WO_QK + WSZ_QK, WO_OUT = WO_VF + WSZ_VF, WO_WI2 = WO_OUT + WSZ_OUT, WO_WO2 = WO_WI2 + WSZ_WI;
constexpr size_t WSZ_LAYER = WO_WO2 + WSZ_WO;
constexpr size_t OFF_PART = OFF_W + 2 * WSZ_LAYER;
constexpr size_t OFF_DUMMY = OFF_PART + (size_t)8 * 32 * 65536 * 4;
constexpr size_t WS_END = OFF_DUMMY + (size_t)T * D * 4;

struct Params {
    const float* x; const float* c; const float* ctx; const float* c_ctx; const float* w_mod; const float* b_mod; const float* norm_w;
    const float* ffn1_wi; const float* ffn1_wo; const float* w_in; const float* q_norm_w; const float* k_norm_w; const float* rpb; const float* w_four;
    const float* w_out; const float* ffn2_wi; const float* ffn2_wo;
    float* out; unsigned char* ws; int ph_lo, ph_hi;
};

typedef const __attribute__((address_space(4))) Params* PP;

__device__ __forceinline__ unsigned pk_bf16(float lo, float hi) { unsigned r; asm("v_cvt_pk_bf16_f32 %0, %1, %2" : "=v"(r) : "v"(lo), "v"(hi)); return r; }
__device__ __forceinline__ float bf_lo(unsigned u) { return __uint_as_float(u << 16); }
__device__ __forceinline__ float bf_hi(unsigned u) { return __uint_as_float(u & 0xffff0000u); }
typedef unsigned u2_t __attribute__((ext_vector_type(2)));
__device__ __forceinline__ float row16_sum(float s) {
    s += __builtin_bit_cast(float, __builtin_amdgcn_update_dpp(0, __builtin_bit_cast(int, s), 0x128, 0xf, 0xf, false));
    s += __builtin_bit_cast(float, __builtin_amdgcn_update_dpp(0, __builtin_bit_cast(int, s), 0x124, 0xf, 0xf, false));
    s += __builtin_bit_cast(float, __builtin_amdgcn_update_dpp(0, __builtin_bit_cast(int, s), 0x122, 0xf, 0xf, false));
    s += __builtin_bit_cast(float, __builtin_amdgcn_update_dpp(0, __builtin_bit_cast(int, s), 0x121, 0xf, 0xf, false));
    return s; }
#define PL_SWAP(op, a, b) asm volatile("s_nop 1\n\t" op " %0, %1" : "+v"(a), "+v"(b))
__device__ __forceinline__ float x16_sum(float x) { float a = x, b = x; PL_SWAP("v_permlane16_swap_b32", a, b); return a + b; }
__device__ __forceinline__ float x32_sum(float x) { float a = x, b = x; PL_SWAP("v_permlane32_swap_b32", a, b); return a + b; }
__device__ __forceinline__ float x16_max(float x) { float a = x, b = x; PL_SWAP("v_permlane16_swap_b32", a, b); return fmaxf(a, b); }
__device__ __forceinline__ float x32_max(float x) { float a = x, b = x; PL_SWAP("v_permlane32_swap_b32", a, b); return fmaxf(a, b); }

namespace pg8 {
constexpr int BM = 256, BK = 64, HALF = 128, HTB = HALF * BK * 2, NXCD = 8, WGM = 8;
__device__ __forceinline__ int lds_byte(int r, int c) { const int st = (r >> 4) * 2 + (c >> 5), rr = r & 15, cc = c & 31, ob = rr * 64 + cc * 2; return st * 1024 + (ob ^ (((ob >> 9) & 1) << 5)); }
__device__ __forceinline__ void stage_rc(int b, int& R, int& C) { const int st = b / 1024, sb = b % 1024, swz = sb ^ (((sb >> 9) & 1) << 5); R = (st >> 1) * 16 + swz / 64; C = (st & 1) * 32 + (swz % 64) / 2; }
__device__ __forceinline__ int perm32(int rho) { const int n = rho >> 4, i = rho & 15; return 8 * (i >> 2) + 4 * n + (i & 3); }

struct Unit { const char* a; const char* b; int pm, pn, kind, nt; };
__device__ __forceinline__ unsigned mkpk(int pm0, int nM, int pn0, int nN, int kind) { return (unsigned)pm0 | ((unsigned)nM << 6) | ((unsigned)pn0 << 12) | ((unsigned)nN << 18) | ((unsigned)kind << 24); }
struct MSched {
    const bf16_t* A0; const bf16_t* B0; const bf16_t* A1; const bf16_t* B1; const bf16_t* A2; const bf16_t* B2; const bf16_t* A3; const bf16_t* B3;
    unsigned pk0, pk1, pk2, pk3; int st1, st2, st3; int total, G, c; size_t tstep; size_t koff3; int ntA, nt3;
    __device__ __forceinline__ bool next(int i, Unit& u) const {
        const int L = i * G + c; if (L >= total) return false;
        const bf16_t* sA = A0; const bf16_t* sB = B0; unsigned spk = pk0; int sst = 0;
        if (L >= st1) { sA = A1; sB = B1; spk = pk1; sst = st1; }
        asm volatile("" : "+s"(sA), "+s"(sB), "+s"(spk), "+s"(sst));
        if (L >= st2) { sA = A2; sB = B2; spk = pk2; sst = st2; }
        asm volatile("" : "+s"(sA), "+s"(sB), "+s"(spk), "+s"(sst));
        size_t skoff = 0; int snt = ntA;
        if (L >= st3) { sA = A3; sB = B3; spk = pk3; sst = st3; skoff = koff3; snt = nt3; }
        asm volatile("" : "+s"(sA), "+s"(sB), "+s"(spk), "+s"(sst), "+s"(skoff), "+s"(snt));
        const int s_pm0 = spk & 63, s_nM = (spk >> 6) & 63, s_pn0 = (spk >> 12) & 63, s_nN = (spk >> 18) & 63, s_kind = spk >> 24;
        int wgid = L - sst; const int nwg = s_nM * s_nN;
        { const int q = nwg / NXCD, r = nwg % NXCD, xcd = wgid % NXCD, off = wgid / NXCD; wgid = (xcd < r ? xcd * (q + 1) : r * (q + 1) + (xcd - r) * q) + off; }
        const int nig = WGM * s_nN, gid = wgid / nig, fm = gid * WGM, gsz = (s_nM - fm) < WGM ? (s_nM - fm) : WGM;
        u.pm = s_pm0 + fm + ((wgid % nig) % gsz); u.pn = s_pn0 + (wgid % nig) / gsz; u.kind = s_kind;
        u.a = (const char*)sA + (size_t)u.pm * tstep + skoff; u.b = (const char*)sB + (size_t)u.pn * tstep + skoff; u.nt = snt; return true;
    }
};
__device__ __forceinline__ MSched sched1(const bf16_t* A, const bf16_t* Bt, int nM, int nN, int kind, int G, int c, size_t tstep, int K) {
    MSched S; S.A0 = A; S.B0 = Bt; S.A1 = A; S.B1 = Bt; S.A2 = A; S.B2 = Bt; S.A3 = A; S.B3 = Bt; S.pk0 = S.pk1 = S.pk2 = S.pk3 = mkpk(0, nM, 0, nN, kind);
    S.st1 = S.st2 = S.st3 = 0x7fffffff; S.total = nM * nN; S.G = G; S.c = c; S.tstep = tstep; S.koff3 = 0; S.ntA = S.nt3 = K / 64; return S; }

template <class Epi>
__device__ __forceinline__ void gemm_phase(LAS unsigned char* lds, const int tid, const int ld, const MSched& S, const Epi& E) {
    const int wid = __builtin_amdgcn_readfirstlane(tid >> 6), lane = tid & 63, wr = wid >> 2, wc = wid & 3, fr = lane & 15, fq = lane >> 4;
    unsigned voffA[2], voffB[2];
#pragma unroll
    for (int i = 0; i < 2; ++i) { int R, C; stage_rc(tid * 16 + i * 8192, R, C); const int Rb = Epi::PERM ? ((R & ~31) + perm32(R & 31)) : R;
        voffA[i] = (unsigned)(R * ld + C) * 2u; voffB[i] = (unsigned)(Rb * ld + C) * 2u; }
    const size_t kstep = (size_t)(BK * 2);
    const size_t hstep = (size_t)HALF * ld * 2;
    const unsigned ldsw = (unsigned)wid * 1024u;
    const int aoff = lds_byte(wr * 64 + fr, fq * 8), boff = lds_byte(wc * 32 + fr, fq * 8);
#define PG8_SA(b, h) (((b) * 2 + (h)) * HTB)
#define PG8_SB(b, h) ((4 + (b) * 2 + (h)) * HTB)
#define PG8_STAGE(bufoff, gbase, voff) do { _Pragma("unroll") for (int _i = 0; _i < 2; ++_i) \
        __builtin_amdgcn_global_load_lds((const unsigned*)((const char*)(gbase) + (voff)[_i]), (LAS unsigned*)(lds + (bufoff) + ldsw + _i * 8192), 16, 0, 0); } while (0)
#define PG8_LDA(dst, b, h) do { _Pragma("unroll") for (int m = 0; m < 4; ++m) _Pragma("unroll") for (int k = 0; k < 2; ++k) dst[m][k] = *(const LAS bf16x8*)(lds + PG8_SA(b, h) + aoff + m * 2048 + k * 1024); } while (0)
#define PG8_LDB(dst, b, h) do { _Pragma("unroll") for (int n = 0; n < 2; ++n) _Pragma("unroll") for (int k = 0; k < 2; ++k) dst[n][k] = *(const LAS bf16x8*)(lds + PG8_SB(b, h) + boff + n * 2048 + k * 1024); } while (0)
#define PG8_MMA(ai, bj, At, Bt) do { __builtin_amdgcn_s_setprio(1); _Pragma("unroll") for (int m = 0; m < 4; ++m) _Pragma("unroll") for (int n = 0; n < 2; ++n) _Pragma("unroll") for (int k = 0; k < 2; ++k) \
        acc[ai][bj][m][n] = __builtin_amdgcn_mfma_f32_16x16x32_bf16(Bt[n][k], At[m][k], acc[ai][bj][m][n], 0, 0, 0); __builtin_amdgcn_s_setprio(0); } while (0)
#define PG8_WAIT_V(n) asm volatile("s_waitcnt vmcnt(" #n ")" ::: "memory")
#define PG8_WAIT_L(n) asm volatile("s_waitcnt lgkmcnt(" #n ")" ::: "memory")
#define PG8_BAR __builtin_amdgcn_s_barrier()
#define PG8_SCHED __builtin_amdgcn_sched_barrier(0)
    Unit cur, nxt; int ui = 0;
    if (!S.next(0, cur)) return;
    f32x4 acc[2][2][4][2];
#pragma unroll
    for (int a = 0; a < 2; ++a)
#pragma unroll
        for (int b = 0; b < 2; ++b)
#pragma unroll
            for (int m = 0; m < 4; ++m)
#pragma unroll
                for (int n = 0; n < 2; ++n) acc[a][b][m][n] = (f32x4){0.f, 0.f, 0.f, 0.f};
    bf16x8 At[4][2], B0[2][2], B1[2][2];
    const char* cA = cur.a; const char* cB = cur.b;
    PG8_STAGE(PG8_SB(0, 0), cB, voffB); PG8_STAGE(PG8_SB(0, 1), cB + hstep, voffB); PG8_STAGE(PG8_SA(0, 0), cA, voffA); PG8_STAGE(PG8_SA(0, 1), cA + hstep, voffA);
    if (wr == 1) PG8_BAR;
    PG8_WAIT_V(2); PG8_BAR;
    PG8_STAGE(PG8_SB(1, 0), cB + kstep, voffB); PG8_STAGE(PG8_SA(1, 0), cA + kstep, voffA); PG8_STAGE(PG8_SB(1, 1), cB + hstep + kstep, voffB);
    PG8_WAIT_V(6); PG8_BAR;
    for (;;) {
        const bool has_next = S.next(ui + 1, nxt);
        const char* nA = has_next ? nxt.a : cA; const char* nB = has_next ? nxt.b : cB;
        const int nt = cur.nt;
        for (int t = 0; t < nt; t += 2) {
            const bool last = (t == nt - 2);
            const char* a1 = cA + (size_t)(t + 1) * kstep;
            const char* a2 = last ? nA : cA + (size_t)(t + 2) * kstep; const char* b2 = last ? nB : cB + (size_t)(t + 2) * kstep;
            const char* a3 = a2 + kstep; const char* b3 = b2 + kstep;
            PG8_LDB(B0, 0, 0); PG8_LDB(B1, 0, 1); PG8_SCHED; PG8_LDA(At, 0, 0); PG8_STAGE(PG8_SA(1, 1), a1 + hstep, voffA);
            PG8_WAIT_V(8); PG8_WAIT_L(0); PG8_BAR; PG8_MMA(0, 0, At, B0); PG8_MMA(0, 1, At, B1); PG8_BAR; PG8_SCHED;
            PG8_LDA(At, 0, 1); PG8_STAGE(PG8_SB(0, 0), b2, voffB); PG8_STAGE(PG8_SB(0, 1), b2 + hstep, voffB); PG8_STAGE(PG8_SA(0, 0), a2, voffA);
            PG8_WAIT_V(8); PG8_WAIT_L(0); PG8_BAR; PG8_MMA(1, 0, At, B0); PG8_MMA(1, 1, At, B1); PG8_BAR; PG8_SCHED;
            PG8_LDB(B0, 1, 0); PG8_LDB(B1, 1, 1); PG8_SCHED; PG8_LDA(At, 1, 0); PG8_STAGE(PG8_SA(0, 1), a2 + hstep, voffA);
            PG8_WAIT_V(8); PG8_WAIT_L(0); PG8_BAR; PG8_MMA(0, 0, At, B0); PG8_MMA(0, 1, At, B1); PG8_BAR; PG8_SCHED;
            PG8_LDA(At, 1, 1); PG8_STAGE(PG8_SB(1, 0), b3, voffB); PG8_STAGE(PG8_SB(1, 1), b3 + hstep, voffB); PG8_STAGE(PG8_SA(1, 0), a3, voffA);
            PG8_WAIT_V(8); PG8_WAIT_L(0); PG8_BAR; PG8_MMA(1, 0, At, B0); PG8_MMA(1, 1, At, B1); PG8_BAR; PG8_SCHED;
        }
        if (wr == 0) PG8_BAR;
        E(acc, cur, wr, wc, fr, fq);
        if (!has_next) break;
#pragma unroll
        for (int a = 0; a < 2; ++a)
#pragma unroll
            for (int b = 0; b < 2; ++b)
#pragma unroll
                for (int m = 0; m < 4; ++m)
#pragma unroll
                    for (int n = 0; n < 2; ++n) acc[a][b][m][n] = (f32x4){0.f, 0.f, 0.f, 0.f};
        cur = nxt; cA = nA; cB = nB; ++ui;
        if (wr == 1) PG8_BAR;
    }
    PG8_WAIT_V(0);
    PG8_BAR;
#undef PG8_SA
#undef PG8_SB
#undef PG8_STAGE
#undef PG8_LDA
#undef PG8_LDB
#undef PG8_MMA
#undef PG8_WAIT_V
#undef PG8_WAIT_L
#undef PG8_BAR
#undef PG8_SCHED
}

struct EpiSwiglu {
    static constexpr bool PERM = true;
    bf16_t* H;
    __device__ __forceinline__ void operator()(const f32x4 (&acc)[2][2][4][2], const Unit& u, int wr, int wc, int fr, int fq) const {
        const int row0 = u.pm * BM + wr * 64 + fr, col0 = u.pn * 128 + wc * 32 + 8 * fq;
#pragma unroll
        for (int ai = 0; ai < 2; ++ai)
#pragma unroll
            for (int m = 0; m < 4; ++m) {
                float h[8];
#pragma unroll
                for (int n = 0; n < 2; ++n)
#pragma unroll
                    for (int j = 0; j < 4; ++j) { const float g = acc[ai][0][m][n][j], uu = acc[ai][1][m][n][j];
                        h[n * 4 + j] = g * __builtin_amdgcn_rcpf(1.0f + __builtin_amdgcn_exp2f(-g * LOG2E)) * uu; }
                u32x4 w; w.x = pk_bf16(h[0], h[1]); w.y = pk_bf16(h[2], h[3]); w.z = pk_bf16(h[4], h[5]); w.w = pk_bf16(h[6], h[7]);
                *(GAS u32x4*)(H + (size_t)(row0 + ai * HALF + m * 16) * FF + col0) = w;
            }
    }
};
struct EpiRes {
    static constexpr bool PERM = false;
    const float* base; float* out_lat; float* out_ctx; const float* gate; float gs; float* part;
    __device__ __forceinline__ void operator()(const f32x4 (&acc)[2][2][4][2], const Unit& u, int wr, int wc, int fr, int fq) const {
        if (u.kind == 1) {
            float* pt = part + (size_t)((u.pm - 32) * 8 + u.pn) * 65536 + (wr * 64 + fr) * 256 + wc * 32 + 4 * fq;
#pragma unroll
            for (int ai = 0; ai < 2; ++ai)
#pragma unroll
                for (int m = 0; m < 4; ++m)
#pragma unroll
                    for (int bj = 0; bj < 2; ++bj)
#pragma unroll
                        for (int n = 0; n < 2; ++n) *(GAS f32x4*)(pt + (ai * HALF + m * 16) * 256 + bj * HALF + n * 16) = acc[ai][bj][m][n];
            return;
        }
        const int row0 = u.pm * BM + wr * 64 + fr, col0 = u.pn * BM + wc * 32 + 4 * fq;
        const bool lat = u.pm < 32; const int b = lat ? (u.pm >> 3) : 4;
        float* out = lat ? out_lat : out_ctx;
        f32x4 gv[2][2];
#pragma unroll
        for (int bj = 0; bj < 2; ++bj)
#pragma unroll
            for (int n = 0; n < 2; ++n) gv[bj][n] = *(const GAS f32x4*)(gate + (size_t)b * NMODC + col0 + bj * HALF + n * 16) * gs;
#pragma unroll
        for (int ai = 0; ai < 2; ++ai)
#pragma unroll
            for (int m = 0; m < 4; ++m) { const size_t off = (size_t)(row0 + ai * HALF + m * 16) * D + col0;
#pragma unroll
                for (int bj = 0; bj < 2; ++bj)
#pragma unroll
                    for (int n = 0; n < 2; ++n) { const f32x4 bs = *(const GAS f32x4*)(base + off + bj * HALF + n * 16);
                        *(GAS f32x4*)(out + off + bj * HALF + n * 16) = bs + gv[bj][n] * acc[ai][bj][m][n]; } }
    }
};
__device__ __forceinline__ u32x4 pack8(const f32x4& a, const f32x4& b) { u32x4 w; w.x = pk_bf16(a[0], a[1]); w.y = pk_bf16(a[2], a[3]); w.z = pk_bf16(b[0], b[1]); w.w = pk_bf16(b[2], b[3]); return w; }
struct EpiWin {
    static constexpr bool PERM = true;
    unsigned char* ws; float* kss;
    __device__ __forceinline__ void operator()(const f32x4 (&acc)[2][2][4][2], const Unit& u, int wr, int wc, int fr, int fq) const {
        const int row0 = u.pm * BM + wr * 64 + fr, col0 = u.pn * BM + wc * 32 + 8 * fq;
        bf16_t* QK = (bf16_t*)(ws + OFF_QK); bf16_t* VtL = (bf16_t*)(ws + OFF_VTL); bf16_t* VtC = (bf16_t*)(ws + OFF_VTC); bf16_t* UtL = (bf16_t*)(ws + OFF_UTL); bf16_t* UtC = (bf16_t*)(ws + OFF_UTC);
        if (u.kind == 0) {
#pragma unroll
            for (int ai = 0; ai < 2; ++ai)
#pragma unroll
                for (int m = 0; m < 4; ++m)
#pragma unroll
                    for (int bj = 0; bj < 2; ++bj)
                        *(GAS u32x4*)(QK + (size_t)(row0 + ai * HALF + m * 16) * 3072 + col0 + bj * HALF) = pack8(acc[ai][bj][m][0], acc[ai][bj][m][1]);
            if (u.pn >= 6) {
#pragma unroll
                for (int ai = 0; ai < 2; ++ai)
#pragma unroll
                    for (int m = 0; m < 4; ++m)
#pragma unroll
                        for (int bj = 0; bj < 2; ++bj) { const f32x4 a = acc[ai][bj][m][0], b = acc[ai][bj][m][1];
                            float ss = (a[0] * a[0] + a[1] * a[1]) + (a[2] * a[2] + a[3] * a[3]) + (b[0] * b[0] + b[1] * b[1]) + (b[2] * b[2] + b[3] * b[3]);
                            ss = x32_sum(x16_sum(ss));
                            if (fq == 0) __hip_atomic_fetch_add((GAS float*)kss + (size_t)(row0 + ai * HALF + m * 16) * 12 + (u.pn - 6) * 2 + bj, ss, __ATOMIC_RELAXED, __HIP_MEMORY_SCOPE_AGENT); }
            }
        } else {
            const bool lat = u.pn < 32; const bool isv = u.pm < 6;
            const int tk0 = lat ? col0 : col0 - TL; const int L = lat ? 2048 : 256; const int lsh = lat ? 11 : 8;
#pragma unroll
            for (int ai = 0; ai < 2; ++ai)
#pragma unroll
                for (int m = 0; m < 4; ++m) { const int f = row0 + ai * HALF + m * 16;
#pragma unroll
                    for (int bj = 0; bj < 2; ++bj) { const int tk = tk0 + bj * HALF, b = tk >> lsh, l = tk & (L - 1);
                        bf16_t* dst;
                        if (isv) dst = (lat ? VtL : VtC) + ((size_t)(b * 1536 + f) << lsh) + l;
                        else { const int f2 = f - 1536, g = f2 >> 8, cs = (f2 >> 7) & 1, d = f2 & 127; dst = (lat ? UtL : UtC) + (((size_t)((b * 4 + g) * 128 + d) * 2 + cs) << lsh) + l; }
                        *(GAS u32x4*)dst = pack8(acc[ai][bj][m][0], acc[ai][bj][m][1]); } }
        }
    }
};
struct EpiDft {
    static constexpr bool PERM = true;
    bf16_t* CAT;
    __device__ __forceinline__ void operator()(const f32x4 (&acc)[2][2][4][2], const Unit& u, int wr, int wc, int fr, int fq) const {
        const int row0 = u.pm * BM + wr * 64 + fr, col0 = u.pn * BM + wc * 32 + 8 * fq;
        const int b = u.pn >> 1; const int tok0 = (u.kind == 0) ? b * 2048 : TL + b * 256;
#pragma unroll
        for (int ai = 0; ai < 2; ++ai)
#pragma unroll
            for (int m = 0; m < 4; ++m)
#pragma unroll
                for (int bj = 0; bj < 2; ++bj)
                    *(GAS u32x4*)(CAT + (size_t)(tok0 + row0 + ai * HALF + m * 16) * D + 1536 + ((col0 + bj * HALF) & 511)) = pack8(acc[ai][bj][m][0], acc[ai][bj][m][1]);
    }
};
}

__device__ __forceinline__ void transpose_unit(LAS unsigned char* lds, const int tid, const float* src, int ldn, int K, int kt, int nt, bf16_t* dst, bf16_t* dst2, int map) {
    LAS float* tile = (LAS float*)lds;
    const int wave = tid >> 6, lane = tid & 63;
    const float* sp = src + (size_t)(kt * 64 + wave) * ldn + nt * 256 + 4 * lane;
    f32x4 v[8];
#pragma unroll
    for (int i = 0; i < 8; ++i) v[i] = __builtin_nontemporal_load((const f32x4*)(sp + (size_t)(8 * i) * ldn));
#pragma unroll
    for (int i = 0; i < 8; ++i) *(LAS f32x4*)(tile + (wave + 8 * i) * 256 + 4 * (lane ^ i)) = v[i];
    __syncthreads();
    const int kc = lane & 7, nl = lane >> 3;
#pragma unroll
    for (int it = 0; it < 4; ++it) {
        const int n = it * 64 + wave * 8 + nl;
        const LAS float* tp = tile + (8 * kc) * 256 + 4 * ((n >> 2) ^ kc) + (n & 3);
        u32x4 w; w.x = pk_bf16(tp[0], tp[256]); w.y = pk_bf16(tp[512], tp[768]); w.z = pk_bf16(tp[1024], tp[1280]); w.w = pk_bf16(tp[1536], tp[1792]);
        const int ng = nt * 256 + n;
        bf16_t* drow;
        if (map == 0) drow = dst + (size_t)ng * K;
        else if (map == 1) { const int isu = ng >= FF, j = isu ? ng - FF : ng; drow = dst + (size_t)((j >> 7) * 256 + isu * 128 + (j & 127)) * K; }
        else { drow = (ng < 3072) ? dst + (size_t)ng * K : dst2 + (size_t)(ng - 3072) * K; }
        __builtin_nontemporal_store(w, (u32x4*)(drow + kt * 64 + 8 * kc));
    }
    __syncthreads();
}

__device__ __forceinline__ void mod_unit(LAS unsigned char* lds, const int tid, PP p, int l, int chunk, int kq, const int rep) {
    const int wave = tid >> 6, lane = tid & 63;
    LAS float* sc = (LAS float*)lds;
    LAS float* red = (LAS float*)(lds + 10240);
    for (int idx = tid; idx < 2560; idx += NTHR) { const int b = idx >> 9, k = idx & 511; const float cv = (b < 4) ? p->c[b * 2048 + kq * 512 + k] : p->c_ctx[kq * 512 + k];
        sc[idx] = cv / (1.0f + __expf(-cv)); }
    __syncthreads();
    const float* wp = p->w_mod + ((size_t)l * 2048 + kq * 512 + wave * 64) * NMODC + chunk * 256 + 4 * lane;
    f32x4 acc[5];
#pragma unroll
    for (int b = 0; b < 5; ++b) acc[b] = (f32x4){0.f, 0.f, 0.f, 0.f};
    for (int k0 = 0; k0 < 64; k0 += 16) {
        f32x4 w[16];
#pragma unroll
        for (int j = 0; j < 16; ++j) w[j] = __builtin_nontemporal_load((const GAS f32x4*)(wp + (size_t)(k0 + j) * NMODC));
#pragma unroll
        for (int j = 0; j < 16; ++j)
#pragma unroll
            for (int b = 0; b < 5; ++b) acc[b] += w[j] * sc[b * 512 + wave * 64 + k0 + j];
    }
#pragma unroll
    for (int b = 0; b < 5; ++b) *(LAS f32x4*)(red + (wave * 5 + b) * 256 + 4 * lane) = acc[b];
    __syncthreads();
    float* mod = (float*)(p->ws + OFF_MOD) + (size_t)l * 5 * NMODC;
    for (int o = tid; o < 1280; o += NTHR) { const int b = o >> 8, cc = o & 255; float s = 0.f;
#pragma unroll
        for (int w = 0; w < 8; ++w) s += red[(w * 5 + b) * 256 + cc];
        if (kq == 0) s += p->b_mod[(size_t)l * NMODC + chunk * 256 + cc];
        if (rep == 0) atomicAdd(mod + (size_t)b * NMODC + chunk * 256 + cc, s); }
    __syncthreads();
}

__device__ __forceinline__ void wcs_unit(LAS unsigned char* lds, const int tid, PP p, int idx) {
    const int l = idx >> 7, g = (idx >> 5) & 3, cs = (idx >> 4) & 1, cp0 = (idx & 15) * 8;
    LAS float* tab = (LAS float*)lds;
    if (tid < 128) tab[tid] = (cs ? sinpif((float)tid * (1.0f / 64.0f)) : cospif((float)tid * (1.0f / 64.0f))) * 0.08838834764831845f;
    __syncthreads();
    const GAS float* w4 = (const GAS float*)p->w_four + (size_t)(l * 4 + g) * 128 * 128;
    float* dst = (float*)(p->ws + OFF_WCS) + (size_t)((l * 4 + g) * 2 + cs) * 128 * 128;
#pragma unroll
    for (int i = 0; i < 2; ++i) { const int o = tid + NTHR * i, cp = cp0 + (o >> 7), d = o & 127; float s = 0.f;
        for (int c8 = 0; c8 < 128; c8 += 8) { float w[8];
#pragma unroll
            for (int q = 0; q < 8; ++q) w[q] = w4[(c8 + q) * 128 + d];
#pragma unroll
            for (int q = 0; q < 8; ++q) s += tab[(cp * (c8 + q)) & 127] * w[q]; }
        dst[cp * 128 + d] = s; }
    __syncthreads();
}
__device__ __forceinline__ void dft_unit(LAS unsigned char* lds, const int tid, PP p, int idx) {
    LAS float* ct = (LAS float*)lds; LAS float* st = ct + 2048;
    const bool big = idx < 256; const int L = big ? 2048 : 256; const float sc = big ? 0.022097086912079608f : 0.0625f, inv = big ? (1.0f / 1024.0f) : (1.0f / 128.0f);
    for (int ph = tid; ph < L; ph += NTHR) { const float a = (float)ph * inv; ct[ph] = cospif(a) * sc; st[ph] = -sinpif(a) * sc; }
    __syncthreads();
    if (big) { bf16_t* dst = (bf16_t*)(p->ws + OFF_DFTL);
        for (int e = tid; e < 8 * 512; e += NTHR) { const int j = idx * 8 + (e >> 9), k8 = (e & 511) * 8; float v[8];
#pragma unroll
            for (int q = 0; q < 8; ++q) { const int k = k8 + q, ph = (j * (k & 2047)) & 2047; v[q] = (k < 2048) ? ct[ph] : st[ph]; }
            *(u32x4*)(dst + (size_t)j * 4096 + k8) = (u32x4){pk_bf16(v[0], v[1]), pk_bf16(v[2], v[3]), pk_bf16(v[4], v[5]), pk_bf16(v[6], v[7])}; }
    } else { bf16_t* dst = (bf16_t*)(p->ws + OFF_DFTC); const int r0 = (idx - 256) * 32;
        for (int e = tid; e < 32 * 64; e += NTHR) { const int j = r0 + (e >> 6), k8 = (e & 63) * 8; float v[8];
#pragma unroll
            for (int q = 0; q < 8; ++q) { const int k = k8 + q, ph = (j * (k & 255)) & 255; v[q] = (k < 256) ? ct[ph] : st[ph]; }
            *(u32x4*)(dst + (size_t)j * 512 + k8) = (u32x4){pk_bf16(v[0], v[1]), pk_bf16(v[2], v[3]), pk_bf16(v[4], v[5]), pk_bf16(v[6], v[7])}; }
    }
    __syncthreads();
}
__device__ __forceinline__ void fold_unit(LAS unsigned char* lds, const int tid, PP p, int idx) {
    const int l = idx >> 7, g = (idx >> 5) & 3, kt = idx & 31;
    LAS float* ws_ = (LAS float*)lds;
    const float* src = p->w_in + ((size_t)l * 2048 + kt * 64) * 5120 + 4608 + g * 128;
    for (int e = tid; e < 64 * 32; e += NTHR) { const int r = e >> 5, c4 = (e & 31) * 4; *(LAS f32x4*)(ws_ + r * 128 + c4) = *(const f32x4*)(src + (size_t)r * 5120 + c4); }
    __syncthreads();
    const int csd = tid & 255, kh = tid >> 8;
    const float* wcs = (const float*)(p->ws + OFF_WCS) + (size_t)((l * 4 + g) * 2 + (csd >> 7)) * 128 * 128 + (csd & 127);
    float acc[32];
#pragma unroll
    for (int j = 0; j < 32; ++j) acc[j] = 0.f;
    for (int c8 = 0; c8 < 128; c8 += 8) {
        float w[8];
#pragma unroll
        for (int i = 0; i < 8; ++i) w[i] = ((const GAS float*)wcs)[(c8 + i) * 128];
#pragma unroll
        for (int j = 0; j < 32; ++j) { const f32x4 v0 = *(const LAS f32x4*)(ws_ + (kh * 32 + j) * 128 + c8), v1 = *(const LAS f32x4*)(ws_ + (kh * 32 + j) * 128 + c8 + 4);
            acc[j] += (v0[0] * w[0] + v0[1] * w[1] + v0[2] * w[2] + v0[3] * w[3]) + (v1[0] * w[4] + v1[1] * w[5] + v1[2] * w[6] + v1[3] * w[7]);
            if ((j & 7) == 7) asm volatile("" ::: "memory"); }
    }
    bf16_t* dst = (bf16_t*)(p->ws + OFF_W + (size_t)l * WSZ_LAYER + WO_VF) + (size_t)(1536 + g * 256 + csd) * D + kt * 64 + kh * 32;
#pragma unroll
    for (int j = 0; j < 4; ++j) *(u32x4*)(dst + 8 * j) = (u32x4){pk_bf16(acc[8 * j], acc[8 * j + 1]), pk_bf16(acc[8 * j + 2], acc[8 * j + 3]), pk_bf16(acc[8 * j + 4], acc[8 * j + 5]), pk_bf16(acc[8 * j + 6], acc[8 * j + 7])};
    __syncthreads();
}

constexpr int CV_WI1_0 = 0, CV_WO1_0 = 1408, CV_WIN_0 = 2112, CV_DFT = 2688, CV_WOUT_0 = 2952, CV_WI2_0 = 3208, CV_WO2_0 = 4616, CV_WI1_1 = 5320, CV_WO1_1 = 6728, CV_WIN_1 = 7432, CV_WOUT_1 = 8008,
              CV_WI2_1 = 8264, CV_WO2_1 = 9672, CV_END = 10376;
__device__ __forceinline__ void conv_unit(LAS unsigned char* lds, const int tid, PP p, int idx) {
    if (idx >= CV_DFT && idx < CV_WOUT_0) { dft_unit(lds, tid, p, idx - CV_DFT); return; }
    const int l = idx >= CV_WI1_1;
    bf16_t* wl = (bf16_t*)(p->ws + OFF_W + (size_t)l * WSZ_LAYER);
    int i;
    if (l == 0) {
        if (idx < CV_WO1_0) { i = idx; transpose_unit(lds, tid, p->ffn1_wi, 2 * FF, D, i % 32, (i / 32 + i % 32) % 44, wl + WO_WI1 / 2, nullptr, 1); }
        else if (idx < CV_WIN_0) { i = idx - CV_WO1_0; transpose_unit(lds, tid, p->ffn1_wo, D, FF, i % 88, (i / 88 + i % 88) % 8, wl + WO_WO1 / 2, nullptr, 0); }
        else if (idx < CV_DFT) { i = idx - CV_WIN_0; transpose_unit(lds, tid, p->w_in, 5120, D, i % 32, (i / 32 + i % 32) % 18, wl + WO_QK / 2, wl + WO_VF / 2, 2); }
        else if (idx < CV_WI2_0) { i = idx - CV_WOUT_0; transpose_unit(lds, tid, p->w_out, D, D, i % 32, (i / 32 + i % 32) % 8, wl + WO_OUT / 2, nullptr, 0); }
        else if (idx < CV_WO2_0) { i = idx - CV_WI2_0; transpose_unit(lds, tid, p->ffn2_wi, 2 * FF, D, i % 32, (i / 32 + i % 32) % 44, wl + WO_WI2 / 2, nullptr, 1); }
        else { i = idx - CV_WO2_0; transpose_unit(lds, tid, p->ffn2_wo, D, FF, i % 88, (i / 88 + i % 88) % 8, wl + WO_WO2 / 2, nullptr, 0); }
    } else {
        if (idx < CV_WO1_1) { i = idx - CV_WI1_1; transpose_unit(lds, tid, p->ffn1_wi + (size_t)D * 2 * FF, 2 * FF, D, i % 32, (i / 32 + i % 32) % 44, wl + WO_WI1 / 2, nullptr, 1); }
        else if (idx < CV_WIN_1) { i = idx - CV_WO1_1; transpose_unit(lds, tid, p->ffn1_wo + (size_t)FF * D, D, FF, i % 88, (i / 88 + i % 88) % 8, wl + WO_WO1 / 2, nullptr, 0); }
        else if (idx < CV_WOUT_1) { i = idx - CV_WIN_1; transpose_unit(lds, tid, p->w_in + (size_t)D * 5120, 5120, D, i % 32, (i / 32 + i % 32) % 18, wl + WO_QK / 2, wl + WO_VF / 2, 2); }
        else if (idx < CV_WI2_1) { i = idx - CV_WOUT_1; transpose_unit(lds, tid, p->w_out + (size_t)D * D, D, D, i % 32, (i / 32 + i % 32) % 8, wl + WO_OUT / 2, nullptr, 0); }
        else if (idx < CV_WO2_1) { i = idx - CV_WI2_1; transpose_unit(lds, tid, p->ffn2_wi + (size_t)D * 2 * FF, 2 * FF, D, i % 32, (i / 32 + i % 32) % 44, wl + WO_WI2 / 2, nullptr, 1); }
        else { i = idx - CV_WO2_1; transpose_unit(lds, tid, p->ffn2_wo + (size_t)FF * D, D, FF, i % 88, (i / 88 + i % 88) % 8, wl + WO_WO2 / 2, nullptr, 0); }
    }
}
__device__ __forceinline__ void conv_range(LAS unsigned char* lds, const int tid, PP p, int lo, int hi, int rank, int nb) { for (int i = lo + rank; i < hi; i += nb) conv_unit(lds, tid, p, i); }

constexpr int P0_MOD = 576, P0_WCS = 256;
__device__ __forceinline__ void prep_phase(LAS unsigned char* lds, const int tid, const int bx, PP p, const int rep) {
    for (int it = bx; it < P0_MOD + P0_WCS + CV_WO1_0; it += gridDim.x) {
        int i = it;
        if (i < P0_MOD) { const int l = i / 288, rem = i % 288; mod_unit(lds, tid, p, l, rem >> 2, rem & 3, rep); continue; }
        i -= P0_MOD;
        if (i < P0_WCS) { wcs_unit(lds, tid, p, i); continue; }
        i -= P0_WCS;
        conv_unit(lds, tid, p, i);
    }
}

constexpr size_t PPLANE = (size_t)32 * 65536;
__device__ __forceinline__ void norm_phase(const int tid, const int bx, unsigned char* ws, const float* xlat, const float* xctx, int nrows, const float* nw, const float* modl, int jshift,
                                           float* Xout, const float* P, const float* pgate, float pgs) {
    const int wave = tid >> 6, lane = tid & 63;
    bf16_t* A = (bf16_t*)(ws + OFF_A);
    const int gw = bx * 8 + wave, hw = gw >> 1; const bool cmode = nrows > TL, even = (gw & 1) == 0;
    for (int k = 0; k < 5; ++k) {
        int row;
        if (cmode) { if (even) { if (k >= 4) break; row = (k == 0) ? TL + hw : (k - 1) * 1024 + hw; } else row = 3072 + hw + 1024 * k; }
        else { if (k >= 4) break; row = gw + 2048 * k; }
        const float* src = (row < TL ? xlat : xctx) + (size_t)row * D;
        const int b = row < TL ? (row >> 11) : 4;
        f32x4 v[8]; float ss = 0.f;
#pragma unroll
        for (int i = 0; i < 8; ++i) v[i] = *(const GAS f32x4*)(src + 4 * (lane + 64 * i));
        if (P && row >= TL) {
            const int rr = row - TL; const float* pp = P + (size_t)((rr >> 8) * 8) * 65536 + (rr & 255) * 256 + 4 * lane;
#pragma unroll
            for (int i = 0; i < 8; ++i) { f32x4 a = (f32x4){0.f, 0.f, 0.f, 0.f};
#pragma unroll
                for (int ks = 0; ks < 8; ++ks) a += *(const GAS f32x4*)(pp + (size_t)ks * PPLANE + (size_t)i * 65536);
                v[i] += a * (*(const GAS f32x4*)(pgate + 4 * (lane + 64 * i)) * pgs); }
        }
        if (Xout && (P == nullptr || row >= TL)) {
#pragma unroll
            for (int i = 0; i < 8; ++i) *(GAS f32x4*)(Xout + (size_t)row * D + 4 * (lane + 64 * i)) = v[i];
        }
#pragma unroll
        for (int i = 0; i < 8; ++i) ss += v[i][0] * v[i][0] + v[i][1] * v[i][1] + v[i][2] * v[i][2] + v[i][3] * v[i][3];
        ss = x32_sum(x16_sum(row16_sum(ss)));
        const float rstd = rsqrtf(ss * (1.0f / 2048.0f) + 1e-6f);
        const float* sh = modl + (size_t)b * NMODC + jshift * 2048; const float* scp = sh + 2048;
#pragma unroll
        for (int i = 0; i < 8; ++i) { const int col = 4 * (lane + 64 * i);
            const f32x4 w = *(const GAS f32x4*)(nw + col), s1 = *(const GAS f32x4*)(scp + col), s0 = *(const GAS f32x4*)(sh + col);
            const f32x4 y = (v[i] * rstd * w) * (s1 + 1.0f) + s0;
            *(GAS u32x2*)(A + (size_t)row * D + col) = (u32x2){pk_bf16(y[0], y[1]), pk_bf16(y[2], y[3])}; }
    }
}

typedef __bf16 bf2_t __attribute__((ext_vector_type(2)));
__device__ __forceinline__ float sumsq8(const u32x4& w, float s) {
#pragma unroll
    for (int i = 0; i < 4; ++i) { const float a = bf_lo(w[i]), b = bf_hi(w[i]); s = fmaf(a, a, s); s = fmaf(b, b, s); } return s; }

constexpr int AT_KP = 272, AT_VP = 144;
constexpr int AT_K = 0, AT_V = AT_K + 2 * 64 * AT_KP, AT_RK = AT_V + 2 * 128 * AT_VP, AT_BUF = AT_RK + 512, AT_BIAS = 2 * AT_BUF, AT_END = AT_BIAS + 2 * 480 * 4;
static_assert(AT_END <= LDS_XB, "attention LDS image");
struct AtStage { u32x4 k[4], v[4]; float ks; };
__device__ __forceinline__ void at_load(AtStage& st, const bf16_t* QK, const bf16_t* VtL, const bf16_t* VtC, const float* kss, int c, int nwin, int b, int hp, int rs, int tid) {
    const int hs = hp * 2 + (tid >> 8), t8 = tid & 255;
    const bool win = c < nwin;
    const int ktok0 = win ? (b * 2048 + (rs + c) * 64) : (TL + b * 256 + 64 * (c - nwin));
    const bf16_t* kp = QK + (size_t)(ktok0 + (t8 >> 4)) * 3072 + 1536 + hs * 128 + 8 * (t8 & 15);
#pragma unroll
    for (int j = 0; j < 4; ++j) st.k[j] = *(const GAS u32x4*)(kp + (size_t)(16 * j) * 3072);
    const bf16_t* vsrc = win ? (VtL + (size_t)(b * 1536 + hs * 128) * 2048 + (rs + c) * 64) : (VtC + (size_t)(b * 1536 + hs * 128) * 256 + 64 * (c - nwin));
    const int vpitch = win ? 2048 : 256;
    const bf16_t* vp = vsrc + (size_t)(t8 >> 3) * vpitch + 8 * (t8 & 7);
#pragma unroll
    for (int j = 0; j < 4; ++j) st.v[j] = *(const GAS u32x4*)(vp + (size_t)(32 * j) * vpitch);
    if (tid < 128) st.ks = ((const GAS float*)kss)[(size_t)(ktok0 + (tid & 63)) * 12 + hp * 2 + (tid >> 6)];
}
__device__ __forceinline__ void at_store(const AtStage& st, LAS unsigned char* lds, int tid) {
    const int sh = tid >> 8, t8 = tid & 255;
#pragma unroll
    for (int j = 0; j < 4; ++j) { const int row = (t8 >> 4) + 16 * j;
        *(LAS u32x4*)(lds + AT_K + (sh * 64 + row) * AT_KP + 16 * (t8 & 15)) = st.k[j]; }
    if (tid < 128) *(LAS float*)(lds + AT_RK + tid * 4) = rsqrtf(st.ks * (1.0f / 128.0f) + 1e-6f);
#pragma unroll
    for (int j = 0; j < 4; ++j) *(LAS u32x4*)(lds + AT_V + (sh * 128 + (t8 >> 3) + 32 * j) * AT_VP + 16 * (t8 & 7)) = st.v[j];
}

#define AT_BAR() do { asm volatile("s_waitcnt lgkmcnt(0)" ::: "memory"); __builtin_amdgcn_s_barrier(); asm volatile("" ::: "memory"); } while (0)
__device__ __forceinline__ void at_compute(LAS unsigned char* lds, LAS unsigned char* ldsb, const int c, const int nwin, const int hh, const int krow, const int fr, const int fq, const int s0, const int cq, const int rs, const int r,
                                           const unsigned vmask, const int (&boff)[8], const bf16x8 (&qf)[4], f32x4 (&O)[8], float& m_run, float& l_run) {
    const bool win = c < nwin;
    const int nsub = win ? 1 : 2;
    for (int sub = 0; sub < nsub; ++sub) {
        const int koff = win ? s0 : 32 * sub;
        const LAS unsigned char* kl = ldsb + AT_K + (hh * 64 + koff + krow) * AT_KP + 16 * fq;
        f32x4 sa = (f32x4){0.f, 0.f, 0.f, 0.f}, sb = (f32x4){0.f, 0.f, 0.f, 0.f};
        {   u32x4 kk[4];
#pragma unroll
            for (int ks = 0; ks < 4; ++ks) kk[ks] = *(const LAS u32x4*)(kl + 64 * ks);
#pragma unroll
            for (int ks = 0; ks < 4; ++ks) sa = __builtin_amdgcn_mfma_f32_16x16x32_bf16(__builtin_bit_cast(bf16x8, kk[ks]), qf[ks], sa, 0, 0, 0);
            asm volatile("" ::: "memory");
#pragma unroll
            for (int ks = 0; ks < 4; ++ks) kk[ks] = *(const LAS u32x4*)(kl + 4 * AT_KP + 64 * ks);
#pragma unroll
            for (int ks = 0; ks < 4; ++ks) sb = __builtin_amdgcn_mfma_f32_16x16x32_bf16(__builtin_bit_cast(bf16x8, kk[ks]), qf[ks], sb, 0, 0, 0);
        }
        const f32x4 rka = *(const LAS f32x4*)(ldsb + AT_RK + (hh * 64 + koff + 8 * fq) * 4), rkb = *(const LAS f32x4*)(ldsb + AT_RK + (hh * 64 + koff + 8 * fq + 4) * 4);
        float s[8];
        if (win) {
            const int rowb = AT_BIAS + (hh * 480 + (rs + c - r + 7) * 31) * 4;
            float bv[8];
#pragma unroll
            for (int e = 0; e < 8; ++e) bv[e] = *(const LAS float*)(lds + rowb + boff[e]);
#pragma unroll
            for (int t = 0; t < 4; ++t) { s[t] = ((vmask >> t) & 1u) ? fmaf(sa[t], rka[t], bv[t]) : -INFINITY; s[4 + t] = ((vmask >> (4 + t)) & 1u) ? fmaf(sb[t], rkb[t], bv[4 + t]) : -INFINITY; }
        } else {
#pragma unroll
            for (int t = 0; t < 4; ++t) { s[t] = sa[t] * rka[t]; s[4 + t] = sb[t] * rkb[t]; }
        }
        float cm = fmaxf(fmaxf(fmaxf(s[0], s[1]), fmaxf(s[2], s[3])), fmaxf(fmaxf(s[4], s[5]), fmaxf(s[6], s[7])));
        cm = x32_max(x16_max(cm));
        const float mn = fmaxf(m_run, cm), alpha = __builtin_amdgcn_exp2f(m_run - mn);
        float ps = 0.f;
#pragma unroll
        for (int e = 0; e < 8; ++e) { s[e] = __builtin_amdgcn_exp2f(s[e] - mn); ps += s[e]; }
        l_run = l_run * alpha + ps; m_run = mn;
        const u32x4 pw = (u32x4){pk_bf16(s[0], s[1]), pk_bf16(s[2], s[3]), pk_bf16(s[4], s[5]), pk_bf16(s[6], s[7])};
        const bf16x8 pf = __builtin_bit_cast(bf16x8, pw);
        const LAS unsigned char* vl = ldsb + AT_V + (hh * 128 + fr) * AT_VP + (koff + 8 * fq) * 2;
#pragma unroll
        for (int half = 0; half < 2; ++half) {
            u32x4 vv[4];
#pragma unroll
            for (int d4 = 0; d4 < 4; ++d4) vv[d4] = *(const LAS u32x4*)(vl + 16 * (4 * half + d4) * AT_VP);
#pragma unroll
            for (int d4 = 0; d4 < 4; ++d4) { const int dt = 4 * half + d4; O[dt] *= alpha; O[dt] = __builtin_amdgcn_mfma_f32_16x16x32_bf16(__builtin_bit_cast(bf16x8, vv[d4]), pf, O[dt], 0, 0, 0); }
            asm volatile("" ::: "memory");
        }
    }
}

__device__ __forceinline__ void attn_block(LAS unsigned char* lds, const int tid, const bf16_t* QK, const bf16_t* VtL, const bf16_t* VtC, bf16_t* CAT, const float* gq, const float* gk, const float* rpbl, const float* kss,
                                           int b, int hp, int r, int qg, bool ctxq, bool ldbias) {
    const int lane = tid & 63, wave = tid >> 6, fr = lane & 15, fq = lane >> 4, hh = wave >> 2, qt = wave & 3, h = hp * 2 + hh;
    const int qtok = ctxq ? (TL + b * 256 + qg * 64 + qt * 16 + fr) : (b * 2048 + r * 64 + qt * 16 + fr);
    const int nwin = ctxq ? 0 : 8, nchunks = nwin + 4;
    const int rs = min(max(r - 4, 0), 24);
    AtStage st;
    at_load(st, QK, VtL, VtC, kss, 0, nwin, b, hp, rs, tid);
    bf16x8 qf[4];
    {
        const GAS u32x4* qp = (const GAS u32x4*)(QK + (size_t)qtok * 3072 + h * 128 + 8 * fq);
        u32x4 qr[4]; float ss = 0.f;
#pragma unroll
        for (int ks = 0; ks < 4; ++ks) { qr[ks] = qp[4 * ks]; ss = sumsq8(qr[ks], ss); }
        ss = x32_sum(x16_sum(ss));
        const float rq = rsqrtf(ss * (1.0f / 128.0f) + 1e-6f) * (0.08838834764831845f * LOG2E);
#pragma unroll
        for (int ks = 0; ks < 4; ++ks) { const int d0 = 32 * ks + 8 * fq;
            const f32x4 ga = *(const GAS f32x4*)(gq + d0) * *(const GAS f32x4*)(gk + d0), gb = *(const GAS f32x4*)(gq + d0 + 4) * *(const GAS f32x4*)(gk + d0 + 4);
            u32x4 w; w.x = pk_bf16(bf_lo(qr[ks].x) * rq * ga[0], bf_hi(qr[ks].x) * rq * ga[1]); w.y = pk_bf16(bf_lo(qr[ks].y) * rq * ga[2], bf_hi(qr[ks].y) * rq * ga[3]);
            w.z = pk_bf16(bf_lo(qr[ks].z) * rq * gb[0], bf_hi(qr[ks].z) * rq * gb[1]); w.w = pk_bf16(bf_lo(qr[ks].w) * rq * gb[2], bf_hi(qr[ks].w) * rq * gb[3]);
            qf[ks] = __builtin_bit_cast(bf16x8, w); }
    }
    if (ldbias) for (int e = tid; e < 2 * 465; e += NTHR) {
 const int sh = e >= 465, i = e - sh * 465; *(LAS float*)(lds + AT_BIAS + (sh * 480 + i) * 4) = ((const GAS float*)rpbl)[(size_t)(hp * 2 + sh) * 465 + i] * LOG2E; }
    at_store(st, lds, tid);
    const int s0 = (qt == 0) ? 0 : (qt == 1) ? 8 : (qt == 2) ? 24 : 32;
    const int cq = 16 * qt + fr, cs = min(max(cq - 8, 0), 48);
    const int lo = cs - (s0 + 8 * fq);
    unsigned vmask = (lo >= 0) ? (0xFFFFu << min(lo, 31)) : (0xFFFFu >> min(-lo, 31));
    asm volatile("" : "+v"(vmask));
    int boff[8];
#pragma unroll
    for (int e = 0; e < 8; ++e) boff[e] = (min(max(s0 + 8 * fq + e - cq, -15), 15) + 15) * 4;
    float m_run = -INFINITY, l_run = 0.f;
    f32x4 O[8];
#pragma unroll
    for (int dt = 0; dt < 8; ++dt) O[dt] = (f32x4){0.f, 0.f, 0.f, 0.f};
    const int krow = 8 * (fr >> 2) + (fr & 3);
    AtStage st2;
    at_load(st, QK, VtL, VtC, kss, 1, nwin, b, hp, rs, tid);
    at_load(st2, QK, VtL, VtC, kss, 2, nwin, b, hp, rs, tid);
    AT_BAR();
    for (int c = 0; c < nchunks; c += 2) {
        at_store(st, lds + AT_BUF, tid);
        if (c + 3 < nchunks) at_load(st, QK, VtL, VtC, kss, c + 3, nwin, b, hp, rs, tid);
        at_compute(lds, lds, c, nwin, hh, krow, fr, fq, s0, cq, rs, r, vmask, boff, qf, O, m_run, l_run);
        AT_BAR();
        if (c + 2 < nchunks) { at_store(st2, lds, tid); if (c + 4 < nchunks) at_load(st2, QK, VtL, VtC, kss, c + 4, nwin, b, hp, rs, tid); }
        at_compute(lds, lds + AT_BUF, c + 1, nwin, hh, krow, fr, fq, s0, cq, rs, r, vmask, boff, qf, O, m_run, l_run);
        AT_BAR();
    }
    l_run = x32_sum(x16_sum(l_run));
    const float inv = 1.0f / l_run;
    bf16_t* op = CAT + (size_t)qtok * D + h * 128 + 4 * fq;
#pragma unroll
    for (int dt = 0; dt < 8; ++dt) *(GAS u32x2*)(op + 16 * dt) = (u32x2){pk_bf16(O[dt][0] * inv, O[dt][1] * inv), pk_bf16(O[dt][2] * inv, O[dt][3] * inv)};
}

#define XB_TMO      128
#define XB_XCNT(j)  (256  + 64 * (j))
#define XB_XSUB(j)  (1280 + 64 * (j))
#define XB_XGEN(j)  (2304 + 64 * (j))
#define XB_TOP      3328
#define XB_TOPGEN   3392
#define XCD_BAR_WORDS 3456
#define XB_SPIN_CAP (1u << 20)
__device__ __forceinline__ unsigned xb_ld(unsigned* p)              { return __hip_atomic_load(p, __ATOMIC_RELAXED, __HIP_MEMORY_SCOPE_AGENT); }
__device__ __forceinline__ unsigned xb_add(unsigned* p, unsigned v) { return __hip_atomic_fetch_add(p, v, __ATOMIC_RELAXED, __HIP_MEMORY_SCOPE_AGENT); }
__device__ __forceinline__ unsigned xb_xcc_id() { return (unsigned)__builtin_amdgcn_s_getreg((3 << 11) | 20) & 0xFu; }
#define XB_SPIN(cond, bar) do { unsigned _sp = 0; while (cond) { __builtin_amdgcn_s_sleep(1); \
    if ((++_sp & 255u) == 0u) { if (xb_ld(&(bar)[XB_TMO])) break; if (_sp > XB_SPIN_CAP) { atomicAdd(&(bar)[XB_TMO], 1u); break; } } } } while (0)
struct XcdBarrier { unsigned* bar; unsigned x; volatile LAS unsigned* st; };
__device__ __forceinline__ XcdBarrier xcd_barrier_post(unsigned* bar, volatile LAS unsigned* st) {
    XcdBarrier b; b.bar = bar; b.x = xb_xcc_id(); b.st = st;
    if (threadIdx.x == 0) (void)xb_add(&bar[XB_XCNT(b.x)], 1u);
    return b;
}
__device__ __forceinline__ void xcd_barrier_complete(unsigned* bar, unsigned x, unsigned& nloc, unsigned& nx) {
    const unsigned G = gridDim.x * gridDim.y * gridDim.z;
    unsigned sum, cnt, mine, sp = 0u;
    for (;;) {
        sum = 0u; cnt = 0u; mine = 0u;
#pragma unroll
        for (unsigned j = 0; j < 16; ++j) { const unsigned c = xb_ld(&bar[XB_XCNT(j)]); sum += c; cnt += (c > 0u) ? 1u : 0u; mine = (j == x) ? c : mine; }
        if (sum == G) break;
        __builtin_amdgcn_s_sleep(1);
        if ((++sp & 255u) == 0u) { if (xb_ld(&bar[XB_TMO])) break; if (sp > XB_SPIN_CAP) { atomicAdd(&bar[XB_TMO], 1u); break; } }
    }
    nloc = mine > 0u ? mine : 1u; nx = cnt > 0u ? cnt : 1u;
}
__device__ __forceinline__ void xcd_barrier(const XcdBarrier& b) {
    asm volatile("s_waitcnt vmcnt(0)" ::: "memory");
    __syncthreads();
    if (threadIdx.x == 0) {
        unsigned* bar = b.bar;
        __builtin_amdgcn_s_waitcnt(0);
        unsigned nloc = b.st[0], nx = b.st[1];
        if (nloc == 0u) { xcd_barrier_complete(bar, b.x, nloc, nx); b.st[0] = nloc; b.st[1] = nx; }
        const unsigned old = xb_add(&bar[XB_XSUB(b.x)], 1u);
        const unsigned gen = old / nloc;
        if (old + 1u == (gen + 1u) * nloc) {
            __builtin_amdgcn_fence(__ATOMIC_RELEASE, "agent");
            asm volatile("s_waitcnt vmcnt(0)" ::: "memory");
            const unsigned og = xb_add(&bar[XB_TOP], 1u);
            const unsigned tg = og / nx;
            if (og + 1u == (tg + 1u) * nx) xb_add(&bar[XB_TOPGEN], 1u);
            else XB_SPIN(xb_ld(&bar[XB_TOPGEN]) == tg, bar);
            __builtin_amdgcn_fence(__ATOMIC_ACQUIRE, "agent");
            xb_add(&bar[XB_XGEN(b.x)], 1u);
            asm volatile("s_waitcnt vmcnt(0)" ::: "memory");
        } else {
            XB_SPIN(xb_ld(&bar[XB_XGEN(b.x)]) == gen, bar);
            __builtin_amdgcn_fence(__ATOMIC_ACQUIRE, "agent");
            asm volatile("s_waitcnt vmcnt(0)" ::: "memory");
        }
    }
    __syncthreads();
}

__global__ void __launch_bounds__(NTHR, 2) fwd_megakernel(Params p_unused) {
    extern __shared__ __attribute__((aligned(16))) unsigned char lds_raw[];
    LAS unsigned char* lds = (LAS unsigned char*)lds_raw;
    cg::grid_group grid = cg::this_grid();
    const int G = gridDim.x;
    const int ph_lo = p_unused.ph_lo, ph_hi = p_unused.ph_hi;
    if (threadIdx.x < 16) ((LAS unsigned*)(lds + LDS_XB))[threadIdx.x] = 0u;
    __syncthreads();
    (void)xcd_barrier_post((unsigned*)(p_unused.ws + OFF_BAR), (volatile LAS unsigned*)(lds + LDS_XB));
    for (int ph = ph_lo; ph < ph_hi; ++ph)
    for (int rep = 0; rep < ((ph == REP_PH) ? 1 + REP_N : 1); ++rep) {
        if (ph > ph_lo || rep > 0) for (int sr = 0; sr < SYNC_REP; ++sr) { if (ph_hi > 1000) grid.sync();
            else {
            XcdBarrier xb; unsigned char* wsb = p_unused.ws; asm volatile("" : "+s"(wsb));
            xb.bar = (unsigned*)(wsb + OFF_BAR); xb.x = xb_xcc_id(); xb.st = (volatile LAS unsigned*)(lds + LDS_XB); xcd_barrier(xb); } }
        PP p = (PP)__builtin_amdgcn_kernarg_segment_ptr(); asm volatile("" : "+s"(p));
        int tid = threadIdx.x, bx = blockIdx.x; unsigned char* ws = p->ws;
        asm volatile("" : "+v"(tid)); asm volatile("" : "+s"(bx)); asm volatile("" : "+s"(ws));
        const int wave = tid >> 6, lane = tid & 63;
    float* X = (float*)(ws + OFF_X); bf16_t* A = (bf16_t*)(ws + OFF_A); bf16_t* H = (bf16_t*)(ws + OFF_H); bf16_t* QK = (bf16_t*)(ws + OFF_QK);
    bf16_t* VtL = (bf16_t*)(ws + OFF_VTL); bf16_t* VtC = (bf16_t*)(ws + OFF_VTC); bf16_t* UtL = (bf16_t*)(ws + OFF_UTL); bf16_t* UtC = (bf16_t*)(ws + OFF_UTC);
    bf16_t* CAT = (bf16_t*)(ws + OFF_CAT); const bf16_t* DFTL = (const bf16_t*)(ws + OFF_DFTL); const bf16_t* DFTC = (const bf16_t*)(ws + OFF_DFTC);
    const float* MOD = (const float*)(ws + OFF_MOD);

        if (ph == 0) { prep_phase(lds, tid, bx, p, rep); continue; }
        const int l = (ph - 1) / 10, sp = (ph - 1) % 10; const bool last = (l == 1);
        const float* modl = MOD + (size_t)l * 5 * NMODC;
        const unsigned char* wl = ws + OFF_W + (size_t)l * WSZ_LAYER;
        if (sp == 0 || sp == 3 || sp == 7) {
            if (ph == 1) for (int it = bx; it < 256; it += G) fold_unit(lds, tid, p, it);
            const bool first = (ph == 1);
            const int nrows = (last && sp == 7) ? TL : T;
            const bool pend = !first && !(last && sp == 7);
            const float* pgate = (sp == 0) ? MOD + 4 * NMODC + 8 * 2048 : modl + 4 * NMODC + (sp == 3 ? 2 : 5) * 2048;
            for (int nrep = 0; nrep < NORM_REP; ++nrep)
            norm_phase(tid, bx, ws, first ? p->x : X, (first || ph == 4) ? p->ctx - (size_t)TL * D : X, nrows,     p->norm_w + (size_t)(l * 3 + (sp == 0 ? 0 : sp == 3 ? 1 : 2)) * D, modl, sp == 0 ? 0 : sp == 3 ? 3 : 6,
                       (nrep == 0 && rep == 0 && pend) ? X : nullptr, (nrep == 0 && rep == 0 && pend) ? (const float*)(ws + OFF_PART) : nullptr, pgate, sp == 7 ? 1.0f : 0.5f);
        } else if (sp == 1 || sp == 8) {
            const int nM = (last && sp == 8) ? 32 : 36;
            const pg8::MSched S = pg8::sched1(A, (const bf16_t*)(wl + (sp == 1 ? WO_WI1 : WO_WI2)), nM, 44, 0, G, bx, (size_t)256 * D * 2, D);
            pg8::EpiSwiglu E{H};
            pg8::gemm_phase(lds, tid, D, S, E);
            if (sp == 1 && !last) { if (bx >= 48) conv_range(lds, tid, p, CV_WO1_0, CV_WI2_0, bx - 48, G - 48); }
            else if (sp == 8 && !last) { if (bx >= 48) conv_range(lds, tid, p, 5936, 7808, bx - 48, G - 48); }
            else if (sp == 1 && last) { if (bx >= 48) conv_range(lds, tid, p, 7808, 9032, bx - 48, G - 48); }
            else { if (bx >= 128) conv_range(lds, tid, p, CV_WO2_1, CV_END, bx - 128, G - 128); }
        } else if (sp == 2 || sp == 9 || sp == 6) {
            const bool fin = last && sp == 9; const bool hasctx = !(last && sp != 2);
            const bf16_t* Am = (sp == 6) ? CAT : H; const int K = (sp == 6) ? D : FF;
            const bf16_t* Bm = (const bf16_t*)(wl + (sp == 2 ? WO_WO1 : sp == 9 ? WO_WO2 : WO_OUT));
            float* dummy = (float*)(ws + OFF_DUMMY);
            {
                const int ks = bx & 7, tile = (bx >> 3) & 31;
                const int np = (sp == 6) ? 2 : (ks < 4 ? 6 : 5), p0 = (sp == 6) ? 2 * ks : (ks < 4 ? 6 * ks : 24 + 5 * (ks - 4));
                pg8::MSched S = pg8::sched1(Am, Bm, 32, 8, 0, G, bx, (size_t)256 * K * 2, K);
                S.pk3 = pg8::mkpk(32 + (tile >> 3), 1, tile & 7, 1, 1); S.st3 = G + bx; S.total = hasctx ? G + bx + 1 : 32 * 8; S.nt3 = np * 2; S.koff3 = (size_t)p0 * 256;
                pg8::EpiRes E{(ph == 3) ? p->x : X, rep ? dummy : fin ? p->out : X,     rep ? dummy : X, modl + (sp == 2 ? 2 : sp == 6 ? 5 : 8) * 2048, sp == 6 ? 1.0f : 0.5f, (float*)(ws + OFF_PART) + (size_t)ks * PPLANE};
                pg8::gemm_phase(lds, tid, K, S, E);
            }
        } else if (sp == 4) {
            const bf16_t* Wqk = (const bf16_t*)(wl + WO_QK); const bf16_t* Wvf = (const bf16_t*)(wl + WO_VF);
            pg8::MSched S; S.G = G; S.c = bx; S.tstep = (size_t)256 * D * 2; S.koff3 = 0; S.ntA = S.nt3 = D / 64;
            S.A0 = A; S.B0 = Wqk; S.A1 = Wvf; S.B1 = A; S.A2 = A; S.B2 = Wqk; S.A3 = Wvf; S.B3 = A;
            S.pk0 = pg8::mkpk(0, last ? 32 : 36, 0, 12, 0); S.pk1 = pg8::mkpk(0, 10, 0, last ? 32 : 36, 1); S.pk2 = pg8::mkpk(32, 4, 6, 6, 0); S.pk3 = pg8::mkpk(0, 6, 32, 4, 1);
            S.st1 = last ? 384 : 432; S.st2 = last ? 704 : 0x7fffffff; S.st3 = last ? 728 : 0x7fffffff; S.total = last ? 752 : 792;
            pg8::EpiWin E{ws, (float*)(ws + OFF_KSS) + (size_t)l * T * 12};
            pg8::gemm_phase(lds, tid, D, S, E);
            if (!last && bx >= 24) conv_range(lds, tid, p, CV_WI2_0, 5296, bx - 24, G - 24);
        } else {
            for (int drep = 0; drep < DFT_REP; ++drep)
            if (bx < 64 || (!last && bx < 72)) {
                const bool dl = bx < 64; const int K = dl ? 4096 : 512;
                const pg8::MSched S = pg8::sched1(dl ? DFTL : DFTC, dl ? UtL : UtC, dl ? 8 : 1, 8, dl ? 0 : 1, dl ? 64 : 8, dl ? bx : bx - 64, (size_t)256 * K * 2, K);
                pg8::EpiDft E{CAT};
#ifndef NO_G4
                pg8::gemm_phase(lds, tid, K, S, E);
#endif
            }
            if (bx < 64) { if (!last) conv_range(lds, tid, p, 5296, 5680, bx, 64); else conv_range(lds, tid, p, 9032, 9416, bx, 64); }
            for (int arep = 0; arep < ATT_REP; ++arep)
            if (bx >= 64) {
                const int nitems = last ? 768 : 768 + 96;
                const float* gq = p->q_norm_w + l * 128; const float* gk = p->k_norm_w + l * 128; const float* rpbl = p->rpb + (size_t)l * 12 * 465;
                for (int it = bx - 64; it < nitems; it += G - 64) {
                    int ab, ahp, ar, aqg; const bool actx = it >= 768;
                    if (!actx) { const int a = it % 192, x = a & 7, j = a >> 3; ahp = 3 * (x & 1) + j % 3; ar = 8 * (x >> 1) + j / 3; ab = it / 192; aqg = 0; }
                    else { const int j = it - 768; ahp = j % 6; aqg = (j / 6) & 3; ab = j / 24; ar = 0; }
                    attn_block(lds, tid, QK, VtL, VtC, CAT, gq, gk, rpbl, (const float*)(ws + OFF_KSS) + (size_t)l * T * 12, ab, ahp, ar, aqg, actx, it == bx - 64);
                }
            }
            if (!last) { if (bx >= 160) conv_range(lds, tid, p, 5680, 5936, bx - 160, 96); }
            else if (bx >= 64) conv_range(lds, tid, p, 9416, CV_WO2_1, bx - 64, G - 64);
        }
    }
}

extern "C" void kernel_launch(void* const* d_in, const int* in_sizes, int n_in, void* d_out, int out_size, void* d_ws, size_t ws_size, hipStream_t stream) {
    static int grid_blocks = 0;
    if (!grid_blocks) {
        int dev = 0, cus = 0, per_cu = 0;
        hipGetDevice(&dev);
        hipDeviceGetAttribute(&cus, hipDeviceAttributeMultiprocessorCount, dev);
        hipFuncSetAttribute((const void*)fwd_megakernel, hipFuncAttributeMaxDynamicSharedMemorySize, LDS_BYTES);
        hipOccupancyMaxActiveBlocksPerMultiprocessor(&per_cu, (const void*)fwd_megakernel, NTHR, LDS_BYTES);
        if (per_cu < 1) { fprintf(stderr, "occupancy query says %d blocks/CU\n", per_cu); per_cu = 1; }
        grid_blocks = cus * 1;
        if (ws_size < WS_END) fprintf(stderr, "workspace too small: %zu < %zu\n", ws_size, (size_t)WS_END);
    }
    Params p{};
    p.x = (const float*)d_in[0]; p.c = (const float*)d_in[1]; p.ctx = (const float*)d_in[2]; p.c_ctx = (const float*)d_in[3]; p.w_mod = (const float*)d_in[4]; p.b_mod = (const float*)d_in[5];
    p.norm_w = (const float*)d_in[6]; p.ffn1_wi = (const float*)d_in[7]; p.ffn1_wo = (const float*)d_in[8]; p.w_in = (const float*)d_in[9]; p.q_norm_w = (const float*)d_in[10];
    p.k_norm_w = (const float*)d_in[11]; p.rpb = (const float*)d_in[12]; p.w_four = (const float*)d_in[13]; p.w_out = (const float*)d_in[14]; p.ffn2_wi = (const float*)d_in[15]; p.ffn2_wo = (const float*)d_in[16];
    p.out = (float*)d_out; p.ws = (unsigned char*)d_ws;
    (void)hipMemsetAsync((char*)d_ws + OFF_BAR, 0, SZ_BAR + SZ_MOD + SZ_KSS, stream);
#if MULTI_LAUNCH
    for (int ph = 0; ph < 21; ++ph) { p.ph_lo = ph; p.ph_hi = ph + 1; hipLaunchKernelGGL(fwd_megakernel, dim3(grid_blocks), dim3(NTHR), LDS_BYTES, stream, p); }
#else
    p.ph_lo = 0; p.ph_hi = 21;
    void* args[] = {&p};
    hipError_t e = hipLaunchCooperativeKernel((const void*)fwd_megakernel, dim3(grid_blocks), dim3(NTHR), args, LDS_BYTES, stream);
    if (e != hipSuccess) fprintf(stderr, "cooperative launch failed: %s (grid %d)\n", hipGetErrorString(e), grid_blocks);
#endif
}
```

```cpp
#include <hip/hip_runtime.h>
#include <hip/hip_cooperative_groups.h>
#include <cstdio>
namespace cg = cooperative_groups;

#define LAS __attribute__((address_space(3)))
#define GAS __attribute__((address_space(1)))
typedef unsigned short bf16_t;
typedef short bf16x8 __attribute__((ext_vector_type(8)));
typedef float f32x4 __attribute__((ext_vector_type(4)));
typedef float f32x2 __attribute__((ext_vector_type(2)));
typedef unsigned u32x4 __attribute__((ext_vector_type(4)));
typedef unsigned u32x2 __attribute__((ext_vector_type(2)));

#ifndef MULTI_LAUNCH
#define MULTI_LAUNCH 0
#endif
#ifndef REP_PH
#define REP_PH (-1)
#endif
#ifndef REP_N
#define REP_N 0
#endif
#define ATT_REP 1
#define DFT_REP 1
#define SYNC_REP 1
#define TAIL_REP 1
#define MAIN_REP 1
#define NORM_REP 1

constexpr int D = 2048, TL = 8192, TC = 1024, T = TL + TC, FF = 5632, NMODC = 9 * 2048;
constexpr int NTHR = 512;
constexpr int LDS_STAGE = 131072;
constexpr int LDS_XB = 148224;
constexpr int LDS_BYTES = LDS_XB + 64;
constexpr float LOG2E = 1.4426950408889634f;

constexpr size_t SZ_MOD = (size_t)2 * 5 * NMODC * 4;
constexpr size_t OFF_BAR = 0;
constexpr size_t SZ_BAR = 16384;
constexpr size_t OFF_MOD = OFF_BAR + SZ_BAR;
constexpr size_t OFF_KSS = OFF_MOD + SZ_MOD;
constexpr size_t SZ_KSS = (size_t)2 * T * 12 * 4;
constexpr size_t OFF_WCS = OFF_KSS + SZ_KSS;
constexpr size_t OFF_X = OFF_WCS + (size_t)2 * 4 * 2 * 128 * 128 * 4;
constexpr size_t OFF_A = OFF_X + (size_t)T * D * 4;
constexpr size_t OFF_H = OFF_A + (size_t)T * D * 2;
constexpr size_t OFF_QK = OFF_H + (size_t)T * FF * 2;
constexpr size_t OFF_VTL = OFF_QK + (size_t)T * 3072 * 2;
constexpr size_t OFF_VTC = OFF_VTL + (size_t)4 * 1536 * 2048 * 2;
constexpr size_t OFF_UTL = OFF_VTC + (size_t)4 * 1536 * 256 * 2;
constexpr size_t OFF_UTC = OFF_UTL + (size_t)2048 * 4096 * 2;
constexpr size_t OFF_CAT = OFF_UTC + (size_t)2048 * 512 * 2;
constexpr size_t OFF_DFTL = OFF_CAT + (size_t)T * D * 2;
constexpr size_t OFF_DFTC = OFF_DFTL + (size_t)2048 * 4096 * 2;
constexpr size_t OFF_W = OFF_DFTC + (size_t)256 * 512 * 2;
constexpr size_t WSZ_WI = (size_t)2 * FF * D * 2, WSZ_WO = (size_t)D * FF * 2, WSZ_QK = (size_t)3072 * D * 2, WSZ_VF = (size_t)2560 * D * 2, WSZ_OUT = (size_t)D * D * 2;
constexpr size_t WO_WI1 = 0, WO_WO1 = WO_WI1 + WSZ_WI, WO_QK = WO_WO1 + WSZ_WO, WO_VF = WO_QK + WSZ_QK, WO_OUT = WO_VF + WSZ_VF, WO_WI2 = WO_OUT + WSZ_OUT, WO_WO2 = WO_WI2 + WSZ_WI;
constexpr size_t WSZ_LAYER = WO_WO2 + WSZ_WO;
constexpr size_t OFF_PART = OFF_W + 2 * WSZ_LAYER;
constexpr size_t OFF_DUMMY = OFF_PART + (size_t)8 * 32 * 65536 * 4;
constexpr size_t WS_END = OFF_DUMMY + (size_t)T * D * 4;

struct Params {
    const float* x; const float* c; const float* ctx; const float* c_ctx; const float* w_mod; const float* b_mod; const float* norm_w;
    const float* ffn1_wi; const float* ffn1_wo; const float* w_in; const float* q_norm_w; const float* k_norm_w; const float* rpb; const float* w_four;
    const float* w_out; const float* ffn2_wi; const float* ffn2_wo;
    float* out; unsigned char* ws; int ph_lo, ph_hi;
};

typedef const __attribute__((address_space(4))) Params* PP;

__device__ __forceinline__ unsigned pk_bf16(float lo, float hi) { unsigned r; asm("v_cvt_pk_bf16_f32 %0, %1, %2" : "=v"(r) : "v"(lo), "v"(hi)); return r; }
__device__ __forceinline__ float bf_lo(unsigned u) { return __uint_as_float(u << 16); }
__device__ __forceinline__ float bf_hi(unsigned u) { return __uint_as_float(u & 0xffff0000u); }
typedef unsigned u2_t __attribute__((ext_vector_type(2)));
__device__ __forceinline__ float row16_sum(float s) {
    s += __builtin_bit_cast(float, __builtin_amdgcn_update_dpp(0, __builtin_bit_cast(int, s), 0x128, 0xf, 0xf, false));
    s += __builtin_bit_cast(float, __builtin_amdgcn_update_dpp(0, __builtin_bit_cast(int, s), 0x124, 0xf, 0xf, false));
    s += __builtin_bit_cast(float, __builtin_amdgcn_update_dpp(0, __builtin_bit_cast(int, s), 0x122, 0xf, 0xf, false));
    s += __builtin_bit_cast(float, __builtin_amdgcn_update_dpp(0, __builtin_bit_cast(int, s), 0x121, 0xf, 0xf, false));
    return s; }
#define PL_SWAP(op, a, b) asm volatile("s_nop 1\n\t" op " %0, %1" : "+v"(a), "+v"(b))
__device__ __forceinline__ float x16_sum(float x) { float a = x, b = x; PL_SWAP("v_permlane16_swap_b32", a, b); return a + b; }
__device__ __forceinline__ float x32_sum(float x) { float a = x, b = x; PL_SWAP("v_permlane32_swap_b32", a, b); return a + b; }
__device__ __forceinline__ float x16_max(float x) { float a = x, b = x; PL_SWAP("v_permlane16_swap_b32", a, b); return fmaxf(a, b); }
__device__ __forceinline__ float x32_max(float x) { float a = x, b = x; PL_SWAP("v_permlane32_swap_b32", a, b); return fmaxf(a, b); }

namespace pg8 {
constexpr int BM = 256, BK = 64, HALF = 128, HTB = HALF * BK * 2, NXCD = 8, WGM = 8;
__device__ __forceinline__ int lds_byte(int r, int c) { const int st = (r >> 4) * 2 + (c >> 5), rr = r & 15, cc = c & 31, ob = rr * 64 + cc * 2; return st * 1024 + (ob ^ (((ob >> 9) & 1) << 5)); }
__device__ __forceinline__ void stage_rc(int b, int& R, int& C) { const int st = b / 1024, sb = b % 1024, swz = sb ^ (((sb >> 9) & 1) << 5); R = (st >> 1) * 16 + swz / 64; C = (st & 1) * 32 + (swz % 64) / 2; }
__device__ __forceinline__ int perm32(int rho) { const int n = rho >> 4, i = rho & 15; return 8 * (i >> 2) + 4 * n + (i & 3); }

struct Unit { const char* a; const char* b; int pm, pn, kind, nt; };
__device__ __forceinline__ unsigned mkpk(int pm0, int nM, int pn0, int nN, int kind) { return (unsigned)pm0 | ((unsigned)nM << 6) | ((unsigned)pn0 << 12) | ((unsigned)nN << 18) | ((unsigned)kind << 24); }
struct MSched {
    const bf16_t* A0; const bf16_t* B0; const bf16_t* A1; const bf16_t* B1; const bf16_t* A2; const bf16_t* B2; const bf16_t* A3; const bf16_t* B3;
    unsigned pk0, pk1, pk2, pk3; int st1, st2, st3; int total, G, c; size_t tstep; size_t koff3; int ntA, nt3;
    __device__ __forceinline__ bool next(int i, Unit& u) const {
        const int L = i * G + c; if (L >= total) return false;
        const bf16_t* sA = A0; const bf16_t* sB = B0; unsigned spk = pk0; int sst = 0;
        if (L >= st1) { sA = A1; sB = B1; spk = pk1; sst = st1; }
        asm volatile("" : "+s"(sA), "+s"(sB), "+s"(spk), "+s"(sst));
        if (L >= st2) { sA = A2; sB = B2; spk = pk2; sst = st2; }
        asm volatile("" : "+s"(sA), "+s"(sB), "+s"(spk), "+s"(sst));
        size_t skoff = 0; int snt = ntA;
        if (L >= st3) { sA = A3; sB = B3; spk = pk3; sst = st3; skoff = koff3; snt = nt3; }
        asm volatile("" : "+s"(sA), "+s"(sB), "+s"(spk), "+s"(sst), "+s"(skoff), "+s"(snt));
        const int s_pm0 = spk & 63, s_nM = (spk >> 6) & 63, s_pn0 = (spk >> 12) & 63, s_nN = (spk >> 18) & 63, s_kind = spk >> 24;
        int wgid = L - sst; const int nwg = s_nM * s_nN;
        { const int q = nwg / NXCD, r = nwg % NXCD, xcd = wgid % NXCD, off = wgid / NXCD; wgid = (xcd < r ? xcd * (q + 1) : r * (q + 1) + (xcd - r) * q) + off; }
        const int nig = WGM * s_nN, gid = wgid / nig, fm = gid * WGM, gsz = (s_nM - fm) < WGM ? (s_nM - fm) : WGM;
        u.pm = s_pm0 + fm + ((wgid % nig) % gsz); u.pn = s_pn0 + (wgid % nig) / gsz; u.kind = s_kind;
        u.a = (const char*)sA + (size_t)u.pm * tstep + skoff; u.b = (const char*)sB + (size_t)u.pn * tstep + skoff; u.nt = snt; return true;
    }
};
__device__ __forceinline__ MSched sched1(const bf16_t* A, const bf16_t* Bt, int nM, int nN, int kind, int G, int c, size_t tstep, int K) {
    MSched S; S.A0 = A; S.B0 = Bt; S.A1 = A; S.B1 = Bt; S.A2 = A; S.B2 = Bt; S.A3 = A; S.B3 = Bt; S.pk0 = S.pk1 = S.pk2 = S.pk3 = mkpk(0, nM, 0, nN, kind);
    S.st1 = S.st2 = S.st3 = 0x7fffffff; S.total = nM * nN; S.G = G; S.c = c; S.tstep = tstep; S.koff3 = 0; S.ntA = S.nt3 = K / 64; return S; }

template <class Epi>
__device__ __forceinline__ void gemm_phase(LAS unsigned char* lds, const int tid, const int ld, const MSched& S, const Epi& E) {
    const int wid = __builtin_amdgcn_readfirstlane(tid >> 6), lane = tid & 63, wr = wid >> 2, wc = wid & 3, fr = lane & 15, fq = lane >> 4;
    unsigned voffA[2], voffB[2];
#pragma unroll
    for (int i = 0; i < 2; ++i) { int R, C; stage_rc(tid * 16 + i * 8192, R, C); const int Rb = Epi::PERM ? ((R & ~31) + perm32(R & 31)) : R;
        voffA[i] = (unsigned)(R * ld + C) * 2u; voffB[i] = (unsigned)(Rb * ld + C) * 2u; }
    const size_t kstep = (size_t)(BK * 2);
    const size_t hstep = (size_t)HALF * ld * 2;
    const unsigned ldsw = (unsigned)wid * 1024u;
    const int aoff = lds_byte(wr * 64 + fr, fq * 8), boff = lds_byte(wc * 32 + fr, fq * 8);
#define PG8_SA(b, h) (((b) * 2 + (h)) * HTB)
#define PG8_SB(b, h) ((4 + (b) * 2 + (h)) * HTB)
#define PG8_STAGE(bufoff, gbase, voff) do { _Pragma("unroll") for (int _i = 0; _i < 2; ++_i) \
        __builtin_amdgcn_global_load_lds((const unsigned*)((const char*)(gbase) + (voff)[_i]), (LAS unsigned*)(lds + (bufoff) + ldsw + _i * 8192), 16, 0, 0); } while (0)
#define PG8_LDA(dst, b, h) do { _Pragma("unroll") for (int m = 0; m < 4; ++m) _Pragma("unroll") for (int k = 0; k < 2; ++k) dst[m][k] = *(const LAS bf16x8*)(lds + PG8_SA(b, h) + aoff + m * 2048 + k * 1024); } while (0)
#define PG8_LDB(dst, b, h) do { _Pragma("unroll") for (int n = 0; n < 2; ++n) _Pragma("unroll") for (int k = 0; k < 2; ++k) dst[n][k] = *(const LAS bf16x8*)(lds + PG8_SB(b, h) + boff + n * 2048 + k * 1024); } while (0)
#define PG8_MMA(ai, bj, At, Bt) do { __builtin_amdgcn_s_setprio(1); _Pragma("unroll") for (int m = 0; m < 4; ++m) _Pragma("unroll") for (int n = 0; n < 2; ++n) _Pragma("unroll") for (int k = 0; k < 2; ++k) \
        acc[ai][bj][m][n] = __builtin_amdgcn_mfma_f32_16x16x32_bf16(Bt[n][k], At[m][k], acc[ai][bj][m][n], 0, 0, 0); __builtin_amdgcn_s_setprio(0); } while (0)
#define PG8_WAIT_V(n) asm volatile("s_waitcnt vmcnt(" #n ")" ::: "memory")
#define PG8_WAIT_L(n) asm volatile("s_waitcnt lgkmcnt(" #n ")" ::: "memory")
#define PG8_BAR __builtin_amdgcn_s_barrier()
#define PG8_SCHED __builtin_amdgcn_sched_barrier(0)
    Unit cur, nxt; int ui = 0;
    if (!S.next(0, cur)) return;
    f32x4 acc[2][2][4][2];
#pragma unroll
    for (int a = 0; a < 2; ++a)
#pragma unroll
        for (int b = 0; b < 2; ++b)
#pragma unroll
            for (int m = 0; m < 4; ++m)
#pragma unroll
                for (int n = 0; n < 2; ++n) acc[a][b][m][n] = (f32x4){0.f, 0.f, 0.f, 0.f};
    bf16x8 At[4][2], B0[2][2], B1[2][2];
    const char* cA = cur.a; const char* cB = cur.b;
    PG8_STAGE(PG8_SB(0, 0), cB, voffB); PG8_STAGE(PG8_SB(0, 1), cB + hstep, voffB); PG8_STAGE(PG8_SA(0, 0), cA, voffA); PG8_STAGE(PG8_SA(0, 1), cA + hstep, voffA);
    if (wr == 1) PG8_BAR;
    PG8_WAIT_V(2); PG8_BAR;
    PG8_STAGE(PG8_SB(1, 0), cB + kstep, voffB); PG8_STAGE(PG8_SA(1, 0), cA + kstep, voffA); PG8_STAGE(PG8_SB(1, 1), cB + hstep + kstep, voffB);
    PG8_WAIT_V(6); PG8_BAR;
    for (;;) {
        const bool has_next = S.next(ui + 1, nxt);
        const char* nA = has_next ? nxt.a : cA; const char* nB = has_next ? nxt.b : cB;
        const int nt = cur.nt;
        for (int t = 0; t < nt; t += 2) {
            const bool last = (t == nt - 2);
            const char* a1 = cA + (size_t)(t + 1) * kstep;
            const char* a2 = last ? nA : cA + (size_t)(t + 2) * kstep; const char* b2 = last ? nB : cB + (size_t)(t + 2) * kstep;
            const char* a3 = a2 + kstep; const char* b3 = b2 + kstep;
            PG8_LDB(B0, 0, 0); PG8_LDB(B1, 0, 1); PG8_SCHED; PG8_LDA(At, 0, 0); PG8_STAGE(PG8_SA(1, 1), a1 + hstep, voffA);
            PG8_WAIT_V(8); PG8_WAIT_L(0); PG8_BAR; PG8_MMA(0, 0, At, B0); PG8_MMA(0, 1, At, B1); PG8_BAR; PG8_SCHED;
            PG8_LDA(At, 0, 1); PG8_STAGE(PG8_SB(0, 0), b2, voffB); PG8_STAGE(PG8_SB(0, 1), b2 + hstep, voffB); PG8_STAGE(PG8_SA(0, 0), a2, voffA);
            PG8_WAIT_V(8); PG8_WAIT_L(0); PG8_BAR; PG8_MMA(1, 0, At, B0); PG8_MMA(1, 1, At, B1); PG8_BAR; PG8_SCHED;
            PG8_LDB(B0, 1, 0); PG8_LDB(B1, 1, 1); PG8_SCHED; PG8_LDA(At, 1, 0); PG8_STAGE(PG8_SA(0, 1), a2 + hstep, voffA);
            PG8_WAIT_V(8); PG8_WAIT_L(0); PG8_BAR; PG8_MMA(0, 0, At, B0); PG8_MMA(0, 1, At, B1); PG8_BAR; PG8_SCHED;
            PG8_LDA(At, 1, 1); PG8_STAGE(PG8_SB(1, 0), b3, voffB); PG8_STAGE(PG8_SB(1, 1), b3 + hstep, voffB); PG8_STAGE(PG8_SA(1, 0), a3, voffA);
            PG8_WAIT_V(8); PG8_WAIT_L(0); PG8_BAR; PG8_MMA(1, 0, At, B0); PG8_MMA(1, 1, At, B1); PG8_BAR; PG8_SCHED;
        }
        if (wr == 0) PG8_BAR;
        E(acc, cur, wr, wc, fr, fq);
        if (!has_next) break;
#pragma unroll
        for (int a = 0; a < 2; ++a)
#pragma unroll
            for (int b = 0; b < 2; ++b)
#pragma unroll
                for (int m = 0; m < 4; ++m)
#pragma unroll
                    for (int n = 0; n < 2; ++n) acc[a][b][m][n] = (f32x4){0.f, 0.f, 0.f, 0.f};
        cur = nxt; cA = nA; cB = nB; ++ui;
        if (wr == 1) PG8_BAR;
    }
    PG8_WAIT_V(0);
    PG8_BAR;
#undef PG8_SA
#undef PG8_SB
#undef PG8_STAGE
#undef PG8_LDA
#undef PG8_LDB
#undef PG8_MMA
#undef PG8_WAIT_V
#undef PG8_WAIT_L
#undef PG8_BAR
#undef PG8_SCHED
}

struct EpiSwiglu {
    static constexpr bool PERM = true;
    bf16_t* H;
    __device__ __forceinline__ void operator()(const f32x4 (&acc)[2][2][4][2], const Unit& u, int wr, int wc, int fr, int fq) const {
        const int row0 = u.pm * BM + wr * 64 + fr, col0 = u.pn * 128 + wc * 32 + 8 * fq;
#pragma unroll
        for (int ai = 0; ai < 2; ++ai)
#pragma unroll
            for (int m = 0; m < 4; ++m) {
                float h[8];
#pragma unroll
                for (int n = 0; n < 2; ++n) {
                    const f32x4 g = acc[ai][0][m][n], uu = acc[ai][1][m][n];
                    const f32x4 t = g * (-LOG2E);
                    f32x4 e; e[0] = __builtin_amdgcn_exp2f(t[0]); e[1] = __builtin_amdgcn_exp2f(t[1]); e[2] = __builtin_amdgcn_exp2f(t[2]); e[3] = __builtin_amdgcn_exp2f(t[3]);
                    const f32x4 d = e + 1.0f;
                    f32x4 r; r[0] = __builtin_amdgcn_rcpf(d[0]); r[1] = __builtin_amdgcn_rcpf(d[1]); r[2] = __builtin_amdgcn_rcpf(d[2]); r[3] = __builtin_amdgcn_rcpf(d[3]);
                    const f32x4 hv = (g * uu) * r;
                    h[n * 4 + 0] = hv[0]; h[n * 4 + 1] = hv[1]; h[n * 4 + 2] = hv[2]; h[n * 4 + 3] = hv[3]; }
                u32x4 w; w.x = pk_bf16(h[0], h[1]); w.y = pk_bf16(h[2], h[3]); w.z = pk_bf16(h[4], h[5]); w.w = pk_bf16(h[6], h[7]);
                *(GAS u32x4*)(H + (size_t)(row0 + ai * HALF + m * 16) * FF + col0) = w;
            }
    }
};
struct EpiRes {
    static constexpr bool PERM = false;
    const float* base; float* out_lat; float* out_ctx; const float* gate; float gs; float* part;
    __device__ __forceinline__ void operator()(const f32x4 (&acc)[2][2][4][2], const Unit& u, int wr, int wc, int fr, int fq) const {
        if (u.kind == 1) {
            float* pt = part + (size_t)((u.pm - 32) * 8 + u.pn) * 65536 + (wr * 64 + fr) * 256 + wc * 32 + 4 * fq;
#pragma unroll
            for (int ai = 0; ai < 2; ++ai)
#pragma unroll
                for (int m = 0; m < 4; ++m)
#pragma unroll
                    for (int bj = 0; bj < 2; ++bj)
#pragma unroll
                        for (int n = 0; n < 2; ++n) *(GAS f32x4*)(pt + (ai * HALF + m * 16) * 256 + bj * HALF + n * 16) = acc[ai][bj][m][n];
            return;
        }
        const int row0 = u.pm * BM + wr * 64 + fr, col0 = u.pn * BM + wc * 32 + 4 * fq;
        const bool lat = u.pm < 32; const int b = lat ? (u.pm >> 3) : 4;
        float* out = lat ? out_lat : out_ctx;
        f32x4 gv[2][2];
#pragma unroll
        for (int bj = 0; bj < 2; ++bj)
#pragma unroll
            for (int n = 0; n < 2; ++n) gv[bj][n] = *(const GAS f32x4*)(gate + (size_t)b * NMODC + col0 + bj * HALF + n * 16) * gs;
#pragma unroll
        for (int ai = 0; ai < 2; ++ai)
#pragma unroll
            for (int m = 0; m < 4; ++m) { const size_t off = (size_t)(row0 + ai * HALF + m * 16) * D + col0;
#pragma unroll
                for (int bj = 0; bj < 2; ++bj)
#pragma unroll
                    for (int n = 0; n < 2; ++n) { const f32x4 bs = *(const GAS f32x4*)(base + off + bj * HALF + n * 16);
                        *(GAS f32x4*)(out + off + bj * HALF + n * 16) = bs + gv[bj][n] * acc[ai][bj][m][n]; } }
    }
};
__device__ __forceinline__ u32x4 pack8(const f32x4& a, const f32x4& b) { u32x4 w; w.x = pk_bf16(a[0], a[1]); w.y = pk_bf16(a[2], a[3]); w.z = pk_bf16(b[0], b[1]); w.w = pk_bf16(b[2], b[3]); return w; }
struct EpiWin {
    static constexpr bool PERM = true;
    unsigned char* ws; float* kss;
    __device__ __forceinline__ void operator()(const f32x4 (&acc)[2][2][4][2], const Unit& u, int wr, int wc, int fr, int fq) const {
        const int row0 = u.pm * BM + wr * 64 + fr, col0 = u.pn * BM + wc * 32 + 8 * fq;
        bf16_t* QK = (bf16_t*)(ws + OFF_QK); bf16_t* VtL = (bf16_t*)(ws + OFF_VTL); bf16_t* VtC = (bf16_t*)(ws + OFF_VTC); bf16_t* UtL = (bf16_t*)(ws + OFF_UTL); bf16_t* UtC = (bf16_t*)(ws + OFF_UTC);
        if (u.kind == 0) {
#pragma unroll
            for (int ai = 0; ai < 2; ++ai)
#pragma unroll
                for (int m = 0; m < 4; ++m)
#pragma unroll
                    for (int bj = 0; bj < 2; ++bj)
                        *(GAS u32x4*)(QK + (size_t)(row0 + ai * HALF + m * 16) * 3072 + col0 + bj * HALF) = pack8(acc[ai][bj][m][0], acc[ai][bj][m][1]);
            if (u.pn >= 6) {
#pragma unroll
                for (int ai = 0; ai < 2; ++ai)
#pragma unroll
                    for (int m = 0; m < 4; ++m)
#pragma unroll
                        for (int bj = 0; bj < 2; ++bj) { const f32x4 a = acc[ai][bj][m][0], b = acc[ai][bj][m][1];
                            float ss = (a[0] * a[0] + a[1] * a[1]) + (a[2] * a[2] + a[3] * a[3]) + (b[0] * b[0] + b[1] * b[1]) + (b[2] * b[2] + b[3] * b[3]);
                            ss = x32_sum(x16_sum(ss));
                            if (fq == 0) __hip_atomic_fetch_add((GAS float*)kss + (size_t)(row0 + ai * HALF + m * 16) * 12 + (u.pn - 6) * 2 + bj, ss, __ATOMIC_RELAXED, __HIP_MEMORY_SCOPE_AGENT); }
            }
        } else {
            const bool lat = u.pn < 32; const bool isv = u.pm < 6;
            const int tk0 = lat ? col0 : col0 - TL; const int L = lat ? 2048 : 256; const int lsh = lat ? 11 : 8;
#pragma unroll
            for (int ai = 0; ai < 2; ++ai)
#pragma unroll
                for (int m = 0; m < 4; ++m) { const int f = row0 + ai * HALF + m * 16;
#pragma unroll
                    for (int bj = 0; bj < 2; ++bj) { const int tk = tk0 + bj * HALF, b = tk >> lsh, l = tk & (L - 1);
                        bf16_t* dst;
                        if (isv) dst = (lat ? VtL : VtC) + ((size_t)(b * 1536 + f) << lsh) + l;
                        else { const int f2 = f - 1536, g = f2 >> 8, cs = (f2 >> 7) & 1, d = f2 & 127; dst = (lat ? UtL : UtC) + (((size_t)((b * 4 + g) * 128 + d) * 2 + cs) << lsh) + l; }
                        *(GAS u32x4*)dst = pack8(acc[ai][bj][m][0], acc[ai][bj][m][1]); } }
        }
    }
};
struct EpiDft {
    static constexpr bool PERM = true;
    bf16_t* CAT;
    __device__ __forceinline__ void operator()(const f32x4 (&acc)[2][2][4][2], const Unit& u, int wr, int wc, int fr, int fq) const {
        const int row0 = u.pm * BM + wr * 64 + fr, col0 = u.pn * BM + wc * 32 + 8 * fq;
        const int b = u.pn >> 1; const int tok0 = (u.kind == 0) ? b * 2048 : TL + b * 256;
#pragma unroll
        for (int ai = 0; ai < 2; ++ai)
#pragma unroll
            for (int m = 0; m < 4; ++m)
#pragma unroll
                for (int bj = 0; bj < 2; ++bj)
                    *(GAS u32x4*)(CAT + (size_t)(tok0 + row0 + ai * HALF + m * 16) * D + 1536 + ((col0 + bj * HALF) & 511)) = pack8(acc[ai][bj][m][0], acc[ai][bj][m][1]);
    }
};
}

__device__ __forceinline__ void transpose_unit(LAS unsigned char* lds, const int tid, const float* src, int ldn, int K, int kt, int nt, bf16_t* dst, bf16_t* dst2, int map) {
    LAS float* tile = (LAS float*)lds;
    const int wave = tid >> 6, lane = tid & 63;
    const float* sp = src + (size_t)(kt * 64 + wave) * ldn + nt * 256 + 4 * lane;
    f32x4 v[8];
#pragma unroll
    for (int i = 0; i < 8; ++i) v[i] = __builtin_nontemporal_load((const f32x4*)(sp + (size_t)(8 * i) * ldn));
#pragma unroll
    for (int i = 0; i < 8; ++i) *(LAS f32x4*)(tile + (wave + 8 * i) * 256 + 4 * (lane ^ i)) = v[i];
    __syncthreads();
    const int kc = lane & 7, nl = lane >> 3;
#pragma unroll
    for (int it = 0; it < 4; ++it) {
        const int n = it * 64 + wave * 8 + nl;
        const LAS float* tp = tile + (8 * kc) * 256 + 4 * ((n >> 2) ^ kc) + (n & 3);
        u32x4 w; w.x = pk_bf16(tp[0], tp[256]); w.y = pk_bf16(tp[512], tp[768]); w.z = pk_bf16(tp[1024], tp[1280]); w.w = pk_bf16(tp[1536], tp[1792]);
        const int ng = nt * 256 + n;
        bf16_t* drow;
        if (map == 0) drow = dst + (size_t)ng * K;
        else if (map == 1) { const int isu = ng >= FF, j = isu ? ng - FF : ng; drow = dst + (size_t)((j >> 7) * 256 + isu * 128 + (j & 127)) * K; }
        else { drow = (ng < 3072) ? dst + (size_t)ng * K : dst2 + (size_t)(ng - 3072) * K; }
        __builtin_nontemporal_store(w, (u32x4*)(drow + kt * 64 + 8 * kc));
    }
    __syncthreads();
}

__device__ __forceinline__ void mod_unit(LAS unsigned char* lds, const int tid, PP p, int l, int chunk, int kq, const int rep) {
    const int wave = tid >> 6, lane = tid & 63;
    LAS float* sc = (LAS float*)lds;
    LAS float* red = (LAS float*)(lds + 10240);
    for (int idx = tid; idx < 2560; idx += NTHR) { const int b = idx >> 9, k = idx & 511; const float cv = (b < 4) ? p->c[b * 2048 + kq * 512 + k] : p->c_ctx[kq * 512 + k];
        sc[idx] = cv / (1.0f + __expf(-cv)); }
    __syncthreads();
    const float* wp = p->w_mod + ((size_t)l * 2048 + kq * 512 + wave * 64) * NMODC + chunk * 256 + 4 * lane;
    f32x4 acc[5];
#pragma unroll
    for (int b = 0; b < 5; ++b) acc[b] = (f32x4){0.f, 0.f, 0.f, 0.f};
    for (int k0 = 0; k0 < 64; k0 += 16) {
        f32x4 w[16];
#pragma unroll
        for (int j = 0; j < 16; ++j) w[j] = __builtin_nontemporal_load((const GAS f32x4*)(wp + (size_t)(k0 + j) * NMODC));
#pragma unroll
        for (int j = 0; j < 16; ++j)
#pragma unroll
            for (int b = 0; b < 5; ++b) acc[b] += w[j] * sc[b * 512 + wave * 64 + k0 + j];
    }
#pragma unroll
    for (int b = 0; b < 5; ++b) *(LAS f32x4*)(red + (wave * 5 + b) * 256 + 4 * lane) = acc[b];
    __syncthreads();
    float* mod = (float*)(p->ws + OFF_MOD) + (size_t)l * 5 * NMODC;
    for (int o = tid; o < 1280; o += NTHR) { const int b = o >> 8, cc = o & 255; float s = 0.f;
#pragma unroll
        for (int w = 0; w < 8; ++w) s += red[(w * 5 + b) * 256 + cc];
        if (kq == 0) s += p->b_mod[(size_t)l * NMODC + chunk * 256 + cc];
        if (rep == 0) atomicAdd(mod + (size_t)b * NMODC + chunk * 256 + cc, s); }
    __syncthreads();
}

__device__ __forceinline__ void wcs_unit(LAS unsigned char* lds, const int tid, PP p, int idx) {
    const int l = idx >> 7, g = (idx >> 5) & 3, cs = (idx >> 4) & 1, cp0 = (idx & 15) * 8;
    LAS float* tab = (LAS float*)lds;
    if (tid < 128) tab[tid] = (cs ? sinpif((float)tid * (1.0f / 64.0f)) : cospif((float)tid * (1.0f / 64.0f))) * 0.08838834764831845f;
    __syncthreads();
    const GAS float* w4 = (const GAS float*)p->w_four + (size_t)(l * 4 + g) * 128 * 128;
    float* dst = (float*)(p->ws + OFF_WCS) + (size_t)((l * 4 + g) * 2 + cs) * 128 * 128;
#pragma unroll
    for (int i = 0; i < 2; ++i) { const int o = tid + NTHR * i, cp = cp0 + (o >> 7), d = o & 127; float s = 0.f;
        for (int c8 = 0; c8 < 128; c8 += 8) { float w[8];
#pragma unroll
            for (int q = 0; q < 8; ++q) w[q] = w4[(c8 + q) * 128 + d];
#pragma unroll
            for (int q = 0; q < 8; ++q) s += tab[(cp * (c8 + q)) & 127] * w[q]; }
        dst[cp * 128 + d] = s; }
    __syncthreads();
}
__device__ __forceinline__ void dft_unit(LAS unsigned char* lds, const int tid, PP p, int idx) {
    LAS float* ct = (LAS float*)lds; LAS float* st = ct + 2048;
    const bool big = idx < 256; const int L = big ? 2048 : 256; const float sc = big ? 0.022097086912079608f : 0.0625f, inv = big ? (1.0f / 1024.0f) : (1.0f / 128.0f);
    for (int ph = tid; ph < L; ph += NTHR) { const float a = (float)ph * inv; ct[ph] = cospif(a) * sc; st[ph] = -sinpif(a) * sc; }
    __syncthreads();
    if (big) { bf16_t* dst = (bf16_t*)(p->ws + OFF_DFTL);
        for (int e = tid; e < 8 * 512; e += NTHR) { const int j = idx * 8 + (e >> 9), k8 = (e & 511) * 8; float v[8];
#pragma unroll
            for (int q = 0; q < 8; ++q) { const int k = k8 + q, ph = (j * (k & 2047)) & 2047; v[q] = (k < 2048) ? ct[ph] : st[ph]; }
            *(u32x4*)(dst + (size_t)j * 4096 + k8) = (u32x4){pk_bf16(v[0], v[1]), pk_bf16(v[2], v[3]), pk_bf16(v[4], v[5]), pk_bf16(v[6], v[7])}; }
    } else { bf16_t* dst = (bf16_t*)(p->ws + OFF_DFTC); const int r0 = (idx - 256) * 32;
        for (int e = tid; e < 32 * 64; e += NTHR) { const int j = r0 + (e >> 6), k8 = (e & 63) * 8; float v[8];
#pragma unroll
            for (int q = 0; q < 8; ++q) { const int k = k8 + q, ph = (j * (k & 255)) & 255; v[q] = (k < 256) ? ct[ph] : st[ph]; }
            *(u32x4*)(dst + (size_t)j * 512 + k8) = (u32x4){pk_bf16(v[0], v[1]), pk_bf16(v[2], v[3]), pk_bf16(v[4], v[5]), pk_bf16(v[6], v[7])}; }
    }
    __syncthreads();
}
__device__ __forceinline__ void fold_unit(LAS unsigned char* lds, const int tid, PP p, int idx) {
    const int l = idx >> 7, g = (idx >> 5) & 3, kt = idx & 31;
    LAS float* ws_ = (LAS float*)lds;
    const float* src = p->w_in + ((size_t)l * 2048 + kt * 64) * 5120 + 4608 + g * 128;
    for (int e = tid; e < 64 * 32; e += NTHR) { const int r = e >> 5, c4 = (e & 31) * 4; *(LAS f32x4*)(ws_ + r * 128 + c4) = *(const f32x4*)(src + (size_t)r * 5120 + c4); }
    __syncthreads();
    const int csd = tid & 255, kh = tid >> 8;
    const float* wcs = (const float*)(p->ws + OFF_WCS) + (size_t)((l * 4 + g) * 2 + (csd >> 7)) * 128 * 128 + (csd & 127);
    float acc[32];
#pragma unroll
    for (int j = 0; j < 32; ++j) acc[j] = 0.f;
    for (int c8 = 0; c8 < 128; c8 += 8) {
        float w[8];
#pragma unroll
        for (int i = 0; i < 8; ++i) w[i] = ((const GAS float*)wcs)[(c8 + i) * 128];
#pragma unroll
        for (int j = 0; j < 32; ++j) { const f32x4 v0 = *(const LAS f32x4*)(ws_ + (kh * 32 + j) * 128 + c8), v1 = *(const LAS f32x4*)(ws_ + (kh * 32 + j) * 128 + c8 + 4);
            acc[j] += (v0[0] * w[0] + v0[1] * w[1] + v0[2] * w[2] + v0[3] * w[3]) + (v1[0] * w[4] + v1[1] * w[5] + v1[2] * w[6] + v1[3] * w[7]);
            if ((j & 7) == 7) asm volatile("" ::: "memory"); }
    }
    bf16_t* dst = (bf16_t*)(p->ws + OFF_W + (size_t)l * WSZ_LAYER + WO_VF) + (size_t)(1536 + g * 256 + csd) * D + kt * 64 + kh * 32;
#pragma unroll
    for (int j = 0; j < 4; ++j) *(u32x4*)(dst + 8 * j) = (u32x4){pk_bf16(acc[8 * j], acc[8 * j + 1]), pk_bf16(acc[8 * j + 2], acc[8 * j + 3]), pk_bf16(acc[8 * j + 4], acc[8 * j + 5]), pk_bf16(acc[8 * j + 6], acc[8 * j + 7])};
    __syncthreads();
}

constexpr int CV_WI1_0 = 0, CV_WO1_0 = 1408, CV_WIN_0 = 2112, CV_DFT = 2688, CV_WOUT_0 = 2952, CV_WI2_0 = 3208, CV_WO2_0 = 4616, CV_WI1_1 = 5320, CV_WO1_1 = 6728, CV_WIN_1 = 7432, CV_WOUT_1 = 8008,
              CV_WI2_1 = 8264, CV_WO2_1 = 9672, CV_END = 10376;
__device__ __forceinline__ void conv_unit(LAS unsigned char* lds, const int tid, PP p, int idx) {
    if (idx >= CV_DFT && idx < CV_WOUT_0) { dft_unit(lds, tid, p, idx - CV_DFT); return; }
    const int l = idx >= CV_WI1_1;
    bf16_t* wl = (bf16_t*)(p->ws + OFF_W + (size_t)l * WSZ_LAYER);
    int i;
    if (l == 0) {
        if (idx < CV_WO1_0) { i = idx; transpose_unit(lds, tid, p->ffn1_wi, 2 * FF, D, i % 32, (i / 32 + i % 32) % 44, wl + WO_WI1 / 2, nullptr, 1); }
        else if (idx < CV_WIN_0) { i = idx - CV_WO1_0; transpose_unit(lds, tid, p->ffn1_wo, D, FF, i % 88, (i / 88 + i % 88) % 8, wl + WO_WO1 / 2, nullptr, 0); }
        else if (idx < CV_DFT) { i = idx - CV_WIN_0; transpose_unit(lds, tid, p->w_in, 5120, D, i % 32, (i / 32 + i % 32) % 18, wl + WO_QK / 2, wl + WO_VF / 2, 2); }
        else if (idx < CV_WI2_0) { i = idx - CV_WOUT_0; transpose_unit(lds, tid, p->w_out, D, D, i % 32, (i / 32 + i % 32) % 8, wl + WO_OUT / 2, nullptr, 0); }
        else if (idx < CV_WO2_0) { i = idx - CV_WI2_0; transpose_unit(lds, tid, p->ffn2_wi, 2 * FF, D, i % 32, (i / 32 + i % 32) % 44, wl + WO_WI2 / 2, nullptr, 1); }
        else { i = idx - CV_WO2_0; transpose_unit(lds, tid, p->ffn2_wo, D, FF, i % 88, (i / 88 + i % 88) % 8, wl + WO_WO2 / 2, nullptr, 0); }
    } else {
        if (idx < CV_WO1_1) { i = idx - CV_WI1_1; transpose_unit(lds, tid, p->ffn1_wi + (size_t)D * 2 * FF, 2 * FF, D, i % 32, (i / 32 + i % 32) % 44, wl + WO_WI1 / 2, nullptr, 1); }
        else if (idx < CV_WIN_1) { i = idx - CV_WO1_1; transpose_unit(lds, tid, p->ffn1_wo + (size_t)FF * D, D, FF, i % 88, (i / 88 + i % 88) % 8, wl + WO_WO1 / 2, nullptr, 0); }
        else if (idx < CV_WOUT_1) { i = idx - CV_WIN_1; transpose_unit(lds, tid, p->w_in + (size_t)D * 5120, 5120, D, i % 32, (i / 32 + i % 32) % 18, wl + WO_QK / 2, wl + WO_VF / 2, 2); }
        else if (idx < CV_WI2_1) { i = idx - CV_WOUT_1; transpose_unit(lds, tid, p->w_out + (size_t)D * D, D, D, i % 32, (i / 32 + i % 32) % 8, wl + WO_OUT / 2, nullptr, 0); }
        else if (idx < CV_WO2_1) { i = idx - CV_WI2_1; transpose_unit(lds, tid, p->ffn2_wi + (size_t)D * 2 * FF, 2 * FF, D, i % 32, (i / 32 + i % 32) % 44, wl + WO_WI2 / 2, nullptr, 1); }
        else { i = idx - CV_WO2_1; transpose_unit(lds, tid, p->ffn2_wo + (size_t)FF * D, D, FF, i % 88, (i / 88 + i % 88) % 8, wl + WO_WO2 / 2, nullptr, 0); }
    }
}
__device__ __forceinline__ void conv_range(LAS unsigned char* lds, const int tid, PP p, int lo, int hi, int rank, int nb) { for (int i = lo + rank; i < hi; i += nb) conv_unit(lds, tid, p, i); }

constexpr int P0_MOD = 576, P0_WCS = 256;
__device__ __forceinline__ void prep_phase(LAS unsigned char* lds, const int tid, const int bx, PP p, const int rep) {
    for (int it = bx; it < P0_MOD + P0_WCS + CV_WO1_0; it += gridDim.x) {
        int i = it;
        if (i < P0_MOD) { const int l = i / 288, rem = i % 288; mod_unit(lds, tid, p, l, rem >> 2, rem & 3, rep); continue; }
        i -= P0_MOD;
        if (i < P0_WCS) { wcs_unit(lds, tid, p, i); continue; }
        i -= P0_WCS;
        conv_unit(lds, tid, p, i);
    }
}

constexpr size_t PPLANE = (size_t)32 * 65536;
__device__ __forceinline__ void norm_phase(const int tid, const int bx, unsigned char* ws, const float* xlat, const float* xctx, int nrows, const float* nw, const float* modl, int jshift,
                                           float* Xout, const float* P, const float* pgate, float pgs) {
    const int wave = tid >> 6, lane = tid & 63;
    bf16_t* A = (bf16_t*)(ws + OFF_A);
    const int gw = bx * 8 + wave, hw = gw >> 1; const bool cmode = nrows > TL, even = (gw & 1) == 0;
    for (int k = 0; k < 5; ++k) {
        int row;
        if (cmode) { if (even) { if (k >= 4) break; row = (k == 0) ? TL + hw : (k - 1) * 1024 + hw; } else row = 3072 + hw + 1024 * k; }
        else { if (k >= 4) break; row = gw + 2048 * k; }
        const float* src = (row < TL ? xlat : xctx) + (size_t)row * D;
        const int b = row < TL ? (row >> 11) : 4;
        f32x4 v[8]; float ss = 0.f;
#pragma unroll
        for (int i = 0; i < 8; ++i) v[i] = *(const GAS f32x4*)(src + 4 * (lane + 64 * i));
        if (P && row >= TL) {
            const int rr = row - TL; const float* pp = P + (size_t)((rr >> 8) * 8) * 65536 + (rr & 255) * 256 + 4 * lane;
#pragma unroll
            for (int i = 0; i < 8; ++i) { f32x4 a = (f32x4){0.f, 0.f, 0.f, 0.f};
#pragma unroll
                for (int ks = 0; ks < 8; ++ks) a += *(const GAS f32x4*)(pp + (size_t)ks * PPLANE + (size_t)i * 65536);
                v[i] += a * (*(const GAS f32x4*)(pgate + 4 * (lane + 64 * i)) * pgs); }
        }
        if (Xout && (P == nullptr || row >= TL)) {
#pragma unroll
            for (int i = 0; i < 8; ++i) *(GAS f32x4*)(Xout + (size_t)row * D + 4 * (lane + 64 * i)) = v[i];
        }
#pragma unroll
        for (int i = 0; i < 8; ++i) ss += v[i][0] * v[i][0] + v[i][1] * v[i][1] + v[i][2] * v[i][2] + v[i][3] * v[i][3];
        ss = x32_sum(x16_sum(row16_sum(ss)));
        const float rstd = rsqrtf(ss * (1.0f / 2048.0f) + 1e-6f);
        const float* sh = modl + (size_t)b * NMODC + jshift * 2048; const float* scp = sh + 2048;
#pragma unroll
        for (int i = 0; i < 8; ++i) { const int col = 4 * (lane + 64 * i);
            const f32x4 w = *(const GAS f32x4*)(nw + col), s1 = *(const GAS f32x4*)(scp + col), s0 = *(const GAS f32x4*)(sh + col);
            const f32x4 y = (v[i] * rstd * w) * (s1 + 1.0f) + s0;
            *(GAS u32x2*)(A + (size_t)row * D + col) = (u32x2){pk_bf16(y[0], y[1]), pk_bf16(y[2], y[3])}; }
    }
}

typedef __bf16 bf2_t __attribute__((ext_vector_type(2)));
__device__ __forceinline__ float sumsq8(const u32x4& w, float s) {
#pragma unroll
    for (int i = 0; i < 4; ++i) { const float a = bf_lo(w[i]), b = bf_hi(w[i]); s = fmaf(a, a, s); s = fmaf(b, b, s); } return s; }

constexpr int AT_KP = 272, AT_VP = 144;
constexpr int AT_K = 0, AT_V = AT_K + 2 * 64 * AT_KP, AT_RK = AT_V + 2 * 128 * AT_VP, AT_BUF = AT_RK + 512, AT_BIAS = 2 * AT_BUF, AT_END = AT_BIAS + 2 * 480 * 4;
static_assert(AT_END <= LDS_XB, "attention LDS image");
struct AtStage { u32x4 k[4], v[4]; float ks; };
__device__ __forceinline__ void at_load(AtStage& st, const bf16_t* QK, const bf16_t* VtL, const bf16_t* VtC, const float* kss, int c, int nwin, int b, int hp, int rs, int tid) {
    const int hs = hp * 2 + (tid >> 8), t8 = tid & 255;
    const bool win = c < nwin;
    const int ktok0 = win ? (b * 2048 + (rs + c) * 64) : (TL + b * 256 + 64 * (c - nwin));
    const bf16_t* kp = QK + (size_t)(ktok0 + (t8 >> 4)) * 3072 + 1536 + hs * 128 + 8 * (t8 & 15);
#pragma unroll
    for (int j = 0; j < 4; ++j) st.k[j] = *(const GAS u32x4*)(kp + (size_t)(16 * j) * 3072);
    const bf16_t* vsrc = win ? (VtL + (size_t)(b * 1536 + hs * 128) * 2048 + (rs + c) * 64) : (VtC + (size_t)(b * 1536 + hs * 128) * 256 + 64 * (c - nwin));
    const int vpitch = win ? 2048 : 256;
    const bf16_t* vp = vsrc + (size_t)(t8 >> 3) * vpitch + 8 * (t8 & 7);
#pragma unroll
    for (int j = 0; j < 4; ++j) st.v[j] = *(const GAS u32x4*)(vp + (size_t)(32 * j) * vpitch);
    if (tid < 128) st.ks = ((const GAS float*)kss)[(size_t)(ktok0 + (tid & 63)) * 12 + hp * 2 + (tid >> 6)];
}
__device__ __forceinline__ void at_store(const AtStage& st, LAS unsigned char* lds, int tid) {
    const int sh = tid >> 8, t8 = tid & 255;
#pragma unroll
    for (int j = 0; j < 4; ++j) { const int row = (t8 >> 4) + 16 * j;
        *(LAS u32x4*)(lds + AT_K + (sh * 64 + row) * AT_KP + 16 * (t8 & 15)) = st.k[j]; }
    if (tid < 128) *(LAS float*)(lds + AT_RK + tid * 4) = rsqrtf(st.ks * (1.0f / 128.0f) + 1e-6f);
#pragma unroll
    for (int j = 0; j < 4; ++j) *(LAS u32x4*)(lds + AT_V + (sh * 128 + (t8 >> 3) + 32 * j) * AT_VP + 16 * (t8 & 7)) = st.v[j];
}

#define AT_BAR() do { asm volatile("s_waitcnt lgkmcnt(0)" ::: "memory"); __builtin_amdgcn_s_barrier(); asm volatile("" ::: "memory"); } while (0)
__device__ __forceinline__ void at_compute(LAS unsigned char* lds, LAS unsigned char* ldsb, const int c, const int nwin, const int hh, const int krow, const int fr, const int fq, const int s0, const int cq, const int rs, const int r,
                                           const unsigned vmask, const int (&boff)[8], const bf16x8 (&qf)[4], f32x4 (&O)[8], float& m_run, float& l_run) {
    const bool win = c < nwin;
    const int nsub = win ? 1 : 2;
    for (int sub = 0; sub < nsub; ++sub) {
        const int koff = win ? s0 : 32 * sub;
        const LAS unsigned char* kl = ldsb + AT_K + (hh * 64 + koff + krow) * AT_KP + 16 * fq;
        f32x4 sa = (f32x4){0.f, 0.f, 0.f, 0.f}, sb = (f32x4){0.f, 0.f, 0.f, 0.f};
        {   u32x4 kk[4];
#pragma unroll
            for (int ks = 0; ks < 4; ++ks) kk[ks] = *(const LAS u32x4*)(kl + 64 * ks);
#pragma unroll
            for (int ks = 0; ks < 4; ++ks) sa = __builtin_amdgcn_mfma_f32_16x16x32_bf16(__builtin_bit_cast(bf16x8, kk[ks]), qf[ks], sa, 0, 0, 0);
            asm volatile("" ::: "memory");
#pragma unroll
            for (int ks = 0; ks < 4; ++ks) kk[ks] = *(const LAS u32x4*)(kl + 4 * AT_KP + 64 * ks);
#pragma unroll
            for (int ks = 0; ks < 4; ++ks) sb = __builtin_amdgcn_mfma_f32_16x16x32_bf16(__builtin_bit_cast(bf16x8, kk[ks]), qf[ks], sb, 0, 0, 0);
        }
        const f32x4 rka = *(const LAS f32x4*)(ldsb + AT_RK + (hh * 64 + koff + 8 * fq) * 4), rkb = *(const LAS f32x4*)(ldsb + AT_RK + (hh * 64 + koff + 8 * fq + 4) * 4);
        float s[8];
        if (win) {
            const int rowb = AT_BIAS + (hh * 480 + (rs + c - r + 7) * 31) * 4;
            float bv[8];
#pragma unroll
            for (int e = 0; e < 8; ++e) bv[e] = *(const LAS float*)(lds + rowb + boff[e]);
#pragma unroll
            for (int t = 0; t < 4; ++t) { s[t] = ((vmask >> t) & 1u) ? fmaf(sa[t], rka[t], bv[t]) : -INFINITY; s[4 + t] = ((vmask >> (4 + t)) & 1u) ? fmaf(sb[t], rkb[t], bv[4 + t]) : -INFINITY; }
        } else {
#pragma unroll
            for (int t = 0; t < 4; ++t) { s[t] = sa[t] * rka[t]; s[4 + t] = sb[t] * rkb[t]; }
        }
        float cm = fmaxf(fmaxf(fmaxf(s[0], s[1]), fmaxf(s[2], s[3])), fmaxf(fmaxf(s[4], s[5]), fmaxf(s[6], s[7])));
        cm = x32_max(x16_max(cm));
        const float mn = fmaxf(m_run, cm), alpha = __builtin_amdgcn_exp2f(m_run - mn);
        float ps = 0.f;
#pragma unroll
        for (int e = 0; e < 8; ++e) { s[e] = __builtin_amdgcn_exp2f(s[e] - mn); ps += s[e]; }
        l_run = l_run * alpha + ps; m_run = mn;
        const u32x4 pw = (u32x4){pk_bf16(s[0], s[1]), pk_bf16(s[2], s[3]), pk_bf16(s[4], s[5]), pk_bf16(s[6], s[7])};
        const bf16x8 pf = __builtin_bit_cast(bf16x8, pw);
        const LAS unsigned char* vl = ldsb + AT_V + (hh * 128 + fr) * AT_VP + (koff + 8 * fq) * 2;
#pragma unroll
        for (int half = 0; half < 2; ++half) {
            u32x4 vv[4];
#pragma unroll
            for (int d4 = 0; d4 < 4; ++d4) vv[d4] = *(const LAS u32x4*)(vl + 16 * (4 * half + d4) * AT_VP);
#pragma unroll
            for (int d4 = 0; d4 < 4; ++d4) { const int dt = 4 * half + d4; O[dt] *= alpha; O[dt] = __builtin_amdgcn_mfma_f32_16x16x32_bf16(__builtin_bit_cast(bf16x8, vv[d4]), pf, O[dt], 0, 0, 0); }
            asm volatile("" ::: "memory");
        }
    }
}

__device__ __forceinline__ void attn_block(LAS unsigned char* lds, const int tid, const bf16_t* QK, const bf16_t* VtL, const bf16_t* VtC, bf16_t* CAT, const float* gq, const float* gk, const float* rpbl, const float* kss,
                                           int b, int hp, int r, int qg, bool ctxq, bool ldbias) {
    const int lane = tid & 63, wave = tid >> 6, fr = lane & 15, fq = lane >> 4, hh = wave >> 2, qt = wave & 3, h = hp * 2 + hh;
    const int qtok = ctxq ? (TL + b * 256 + qg * 64 + qt * 16 + fr) : (b * 2048 + r * 64 + qt * 16 + fr);
    const int nwin = ctxq ? 0 : 8, nchunks = nwin + 4;
    const int rs = min(max(r - 4, 0), 24);
    AtStage st;
    at_load(st, QK, VtL, VtC, kss, 0, nwin, b, hp, rs, tid);
    bf16x8 qf[4];
    {
        const GAS u32x4* qp = (const GAS u32x4*)(QK + (size_t)qtok * 3072 + h * 128 + 8 * fq);
        u32x4 qr[4]; float ss = 0.f;
#pragma unroll
        for (int ks = 0; ks < 4; ++ks) { qr[ks] = qp[4 * ks]; ss = sumsq8(qr[ks], ss); }
        ss = x32_sum(x16_sum(ss));
        const float rq = rsqrtf(ss * (1.0f / 128.0f) + 1e-6f) * (0.08838834764831845f * LOG2E);
#pragma unroll
        for (int ks = 0; ks < 4; ++ks) { const int d0 = 32 * ks + 8 * fq;
            const f32x4 ga = *(const GAS f32x4*)(gq + d0) * *(const GAS f32x4*)(gk + d0), gb = *(const GAS f32x4*)(gq + d0 + 4) * *(const GAS f32x4*)(gk + d0 + 4);
            u32x4 w; w.x = pk_bf16(bf_lo(qr[ks].x) * rq * ga[0], bf_hi(qr[ks].x) * rq * ga[1]); w.y = pk_bf16(bf_lo(qr[ks].y) * rq * ga[2], bf_hi(qr[ks].y) * rq * ga[3]);
            w.z = pk_bf16(bf_lo(qr[ks].z) * rq * gb[0], bf_hi(qr[ks].z) * rq * gb[1]); w.w = pk_bf16(bf_lo(qr[ks].w) * rq * gb[2], bf_hi(qr[ks].w) * rq * gb[3]);
            qf[ks] = __builtin_bit_cast(bf16x8, w); }
    }
    if (ldbias) for (int e = tid; e < 2 * 465; e += NTHR) {
 const int sh = e >= 465, i = e - sh * 465; *(LAS float*)(lds + AT_BIAS + (sh * 480 + i) * 4) = ((const GAS float*)rpbl)[(size_t)(hp * 2 + sh) * 465 + i] * LOG2E; }
    at_store(st, lds, tid);
    const int s0 = (qt == 0) ? 0 : (qt == 1) ? 8 : (qt == 2) ? 24 : 32;
    const int cq = 16 * qt + fr, cs = min(max(cq - 8, 0), 48);
    const int lo = cs - (s0 + 8 * fq);
    unsigned vmask = (lo >= 0) ? (0xFFFFu << min(lo, 31)) : (0xFFFFu >> min(-lo, 31));
    asm volatile("" : "+v"(vmask));
    int boff[8];
#pragma unroll
    for (int e = 0; e < 8; ++e) boff[e] = (min(max(s0 + 8 * fq + e - cq, -15), 15) + 15) * 4;
    float m_run = -INFINITY, l_run = 0.f;
    f32x4 O[8];
#pragma unroll
    for (int dt = 0; dt < 8; ++dt) O[dt] = (f32x4){0.f, 0.f, 0.f, 0.f};
    const int krow = 8 * (fr >> 2) + (fr & 3);
    AtStage st2;
    at_load(st, QK, VtL, VtC, kss, 1, nwin, b, hp, rs, tid);
    at_load(st2, QK, VtL, VtC, kss, 2, nwin, b, hp, rs, tid);
    AT_BAR();
    for (int c = 0; c < nchunks; c += 2) {
        at_store(st, lds + AT_BUF, tid);
        if (c + 3 < nchunks) at_load(st, QK, VtL, VtC, kss, c + 3, nwin, b, hp, rs, tid);
        at_compute(lds, lds, c, nwin, hh, krow, fr, fq, s0, cq, rs, r, vmask, boff, qf, O, m_run, l_run);
        AT_BAR();
        if (c + 2 < nchunks) { at_store(st2, lds, tid); if (c + 4 < nchunks) at_load(st2, QK, VtL, VtC, kss, c + 4, nwin, b, hp, rs, tid); }
        at_compute(lds, lds + AT_BUF, c + 1, nwin, hh, krow, fr, fq, s0, cq, rs, r, vmask, boff, qf, O, m_run, l_run);
        AT_BAR();
    }
    l_run = x32_sum(x16_sum(l_run));
    const float inv = 1.0f / l_run;
    bf16_t* op = CAT + (size_t)qtok * D + h * 128 + 4 * fq;
#pragma unroll
    for (int dt = 0; dt < 8; ++dt) *(GAS u32x2*)(op + 16 * dt) = (u32x2){pk_bf16(O[dt][0] * inv, O[dt][1] * inv), pk_bf16(O[dt][2] * inv, O[dt][3] * inv)};
}

#define XB_TMO      128
#define XB_XCNT(j)  (256  + 64 * (j))
#define XB_XSUB(j)  (1280 + 64 * (j))
#define XB_XGEN(j)  (2304 + 64 * (j))
#define XB_TOP      3328
#define XB_TOPGEN   3392
#define XCD_BAR_WORDS 3456
#define XB_SPIN_CAP (1u << 20)
__device__ __forceinline__ unsigned xb_ld(unsigned* p)              { return __hip_atomic_load(p, __ATOMIC_RELAXED, __HIP_MEMORY_SCOPE_AGENT); }
__device__ __forceinline__ unsigned xb_add(unsigned* p, unsigned v) { return __hip_atomic_fetch_add(p, v, __ATOMIC_RELAXED, __HIP_MEMORY_SCOPE_AGENT); }
__device__ __forceinline__ unsigned xb_xcc_id() { return (unsigned)__builtin_amdgcn_s_getreg((3 << 11) | 20) & 0xFu; }
#define XB_SPIN(cond, bar) do { unsigned _sp = 0; while (cond) { __builtin_amdgcn_s_sleep(1); \
    if ((++_sp & 255u) == 0u) { if (xb_ld(&(bar)[XB_TMO])) break; if (_sp > XB_SPIN_CAP) { atomicAdd(&(bar)[XB_TMO], 1u); break; } } } } while (0)
struct XcdBarrier { unsigned* bar; unsigned x; volatile LAS unsigned* st; };
__device__ __forceinline__ XcdBarrier xcd_barrier_post(unsigned* bar, volatile LAS unsigned* st) {
    XcdBarrier b; b.bar = bar; b.x = xb_xcc_id(); b.st = st;
    if (threadIdx.x == 0) (void)xb_add(&bar[XB_XCNT(b.x)], 1u);
    return b;
}
__device__ __forceinline__ void xcd_barrier_complete(unsigned* bar, unsigned x, unsigned& nloc, unsigned& nx) {
    const unsigned G = gridDim.x * gridDim.y * gridDim.z;
    unsigned sum, cnt, mine, sp = 0u;
    for (;;) {
        sum = 0u; cnt = 0u; mine = 0u;
#pragma unroll
        for (unsigned j = 0; j < 16; ++j) { const unsigned c = xb_ld(&bar[XB_XCNT(j)]); sum += c; cnt += (c > 0u) ? 1u : 0u; mine = (j == x) ? c : mine; }
        if (sum == G) break;
        __builtin_amdgcn_s_sleep(1);
        if ((++sp & 255u) == 0u) { if (xb_ld(&bar[XB_TMO])) break; if (sp > XB_SPIN_CAP) { atomicAdd(&bar[XB_TMO], 1u); break; } }
    }
    nloc = mine > 0u ? mine : 1u; nx = cnt > 0u ? cnt : 1u;
}
__device__ __forceinline__ void xcd_barrier(const XcdBarrier& b) {
    asm volatile("s_waitcnt vmcnt(0)" ::: "memory");
    __syncthreads();
    if (threadIdx.x == 0) {
        unsigned* bar = b.bar;
        __builtin_amdgcn_s_waitcnt(0);
        unsigned nloc = b.st[0], nx = b.st[1];
        if (nloc == 0u) { xcd_barrier_complete(bar, b.x, nloc, nx); b.st[0] = nloc; b.st[1] = nx; }
        const unsigned old = xb_add(&bar[XB_XSUB(b.x)], 1u);
        const unsigned gen = old / nloc;
        if (old + 1u == (gen + 1u) * nloc) {
            __builtin_amdgcn_fence(__ATOMIC_RELEASE, "agent");
            asm volatile("s_waitcnt vmcnt(0)" ::: "memory");
            const unsigned og = xb_add(&bar[XB_TOP], 1u);
            const unsigned tg = og / nx;
            if (og + 1u == (tg + 1u) * nx) xb_add(&bar[XB_TOPGEN], 1u);
            else XB_SPIN(xb_ld(&bar[XB_TOPGEN]) == tg, bar);
            __builtin_amdgcn_fence(__ATOMIC_ACQUIRE, "agent");
            xb_add(&bar[XB_XGEN(b.x)], 1u);
            asm volatile("s_waitcnt vmcnt(0)" ::: "memory");
        } else {
            XB_SPIN(xb_ld(&bar[XB_XGEN(b.x)]) == gen, bar);
            __builtin_amdgcn_fence(__ATOMIC_ACQUIRE, "agent");
            asm volatile("s_waitcnt vmcnt(0)" ::: "memory");
        }
    }
    __syncthreads();
}

__global__ void __launch_bounds__(NTHR, 2) fwd_megakernel(Params p_unused) {
    extern __shared__ __attribute__((aligned(16))) unsigned char lds_raw[];
    LAS unsigned char* lds = (LAS unsigned char*)lds_raw;
    cg::grid_group grid = cg::this_grid();
    const int G = gridDim.x;
    const int ph_lo = p_unused.ph_lo, ph_hi = p_unused.ph_hi;
    if (threadIdx.x < 16) ((LAS unsigned*)(lds + LDS_XB))[threadIdx.x] = 0u;
    __syncthreads();
    (void)xcd_barrier_post((unsigned*)(p_unused.ws + OFF_BAR), (volatile LAS unsigned*)(lds + LDS_XB));
    for (int ph = ph_lo; ph < ph_hi; ++ph)
    for (int rep = 0; rep < ((ph == REP_PH) ? 1 + REP_N : 1); ++rep) {
        if (ph > ph_lo || rep > 0) for (int sr = 0; sr < SYNC_REP; ++sr) { if (ph_hi > 1000) grid.sync();
            else {
            XcdBarrier xb; unsigned char* wsb = p_unused.ws; asm volatile("" : "+s"(wsb));
            xb.bar = (unsigned*)(wsb + OFF_BAR); xb.x = xb_xcc_id(); xb.st = (volatile LAS unsigned*)(lds + LDS_XB); xcd_barrier(xb); } }
        PP p = (PP)__builtin_amdgcn_kernarg_segment_ptr(); asm volatile("" : "+s"(p));
        int tid = threadIdx.x, bx = blockIdx.x; unsigned char* ws = p->ws;
        asm volatile("" : "+v"(tid)); asm volatile("" : "+s"(bx)); asm volatile("" : "+s"(ws));
        const int wave = tid >> 6, lane = tid & 63;
    float* X = (float*)(ws + OFF_X); bf16_t* A = (bf16_t*)(ws + OFF_A); bf16_t* H = (bf16_t*)(ws + OFF_H); bf16_t* QK = (bf16_t*)(ws + OFF_QK);
    bf16_t* VtL = (bf16_t*)(ws + OFF_VTL); bf16_t* VtC = (bf16_t*)(ws + OFF_VTC); bf16_t* UtL = (bf16_t*)(ws + OFF_UTL); bf16_t* UtC = (bf16_t*)(ws + OFF_UTC);
    bf16_t* CAT = (bf16_t*)(ws + OFF_CAT); const bf16_t* DFTL = (const bf16_t*)(ws + OFF_DFTL); const bf16_t* DFTC = (const bf16_t*)(ws + OFF_DFTC);
    const float* MOD = (const float*)(ws + OFF_MOD);

        if (ph == 0) { prep_phase(lds, tid, bx, p, rep); continue; }
        const int l = (ph - 1) / 10, sp = (ph - 1) % 10; const bool last = (l == 1);
        const float* modl = MOD + (size_t)l * 5 * NMODC;
        const unsigned char* wl = ws + OFF_W + (size_t)l * WSZ_LAYER;
        if (sp == 0 || sp == 3 || sp == 7) {
            if (ph == 1) for (int it = bx; it < 256; it += G) fold_unit(lds, tid, p, it);
            const bool first = (ph == 1);
            const int nrows = (last && sp == 7) ? TL : T;
            const bool pend = !first && !(last && sp == 7);
            const float* pgate = (sp == 0) ? MOD + 4 * NMODC + 8 * 2048 : modl + 4 * NMODC + (sp == 3 ? 2 : 5) * 2048;
            for (int nrep = 0; nrep < NORM_REP; ++nrep)
            norm_phase(tid, bx, ws, first ? p->x : X, (first || ph == 4) ? p->ctx - (size_t)TL * D : X, nrows,     p->norm_w + (size_t)(l * 3 + (sp == 0 ? 0 : sp == 3 ? 1 : 2)) * D, modl, sp == 0 ? 0 : sp == 3 ? 3 : 6,
                       (nrep == 0 && rep == 0 && pend) ? X : nullptr, (nrep == 0 && rep == 0 && pend) ? (const float*)(ws + OFF_PART) : nullptr, pgate, sp == 7 ? 1.0f : 0.5f);
        } else if (sp == 1 || sp == 8) {
            const int nM = (last && sp == 8) ? 32 : 36;
            const pg8::MSched S = pg8::sched1(A, (const bf16_t*)(wl + (sp == 1 ? WO_WI1 : WO_WI2)), nM, 44, 0, G, bx, (size_t)256 * D * 2, D);
            pg8::EpiSwiglu E{H};
            pg8::gemm_phase(lds, tid, D, S, E);
            if (sp == 1 && !last) { if (bx >= 48) conv_range(lds, tid, p, CV_WO1_0, CV_WI2_0, bx - 48, G - 48); }
            else if (sp == 8 && !last) { if (bx >= 48) conv_range(lds, tid, p, 5936, 7808, bx - 48, G - 48); }
            else if (sp == 1 && last) { if (bx >= 48) conv_range(lds, tid, p, 7808, 9032, bx - 48, G - 48); }
            else { if (bx >= 128) conv_range(lds, tid, p, CV_WO2_1, CV_END, bx - 128, G - 128); }
        } else if (sp == 2 || sp == 9 || sp == 6) {
            const bool fin = last && sp == 9; const bool hasctx = !(last && sp != 2);
            const bf16_t* Am = (sp == 6) ? CAT : H; const int K = (sp == 6) ? D : FF;
            const bf16_t* Bm = (const bf16_t*)(wl + (sp == 2 ? WO_WO1 : sp == 9 ? WO_WO2 : WO_OUT));
            float* dummy = (float*)(ws + OFF_DUMMY);
            {
                const int ks = bx & 7, tile = (bx >> 3) & 31;
                const int np = (sp == 6) ? 2 : (ks < 4 ? 6 : 5), p0 = (sp == 6) ? 2 * ks : (ks < 4 ? 6 * ks : 24 + 5 * (ks - 4));
                pg8::MSched S = pg8::sched1(Am, Bm, 32, 8, 0, G, bx, (size_t)256 * K * 2, K);
                S.pk3 = pg8::mkpk(32 + (tile >> 3), 1, tile & 7, 1, 1); S.st3 = G + bx; S.total = hasctx ? G + bx + 1 : 32 * 8; S.nt3 = np * 2; S.koff3 = (size_t)p0 * 256;
                pg8::EpiRes E{(ph == 3) ? p->x : X, rep ? dummy : fin ? p->out : X,     rep ? dummy : X, modl + (sp == 2 ? 2 : sp == 6 ? 5 : 8) * 2048, sp == 6 ? 1.0f : 0.5f, (float*)(ws + OFF_PART) + (size_t)ks * PPLANE};
                pg8::gemm_phase(lds, tid, K, S, E);
            }
        } else if (sp == 4) {
            const bf16_t* Wqk = (const bf16_t*)(wl + WO_QK); const bf16_t* Wvf = (const bf16_t*)(wl + WO_VF);
            pg8::MSched S; S.G = G; S.c = bx; S.tstep = (size_t)256 * D * 2; S.koff3 = 0; S.ntA = S.nt3 = D / 64;
            S.A0 = A; S.B0 = Wqk; S.A1 = Wvf; S.B1 = A; S.A2 = A; S.B2 = Wqk; S.A3 = Wvf; S.B3 = A;
            S.pk0 = pg8::mkpk(0, last ? 32 : 36, 0, 12, 0); S.pk1 = pg8::mkpk(0, 10, 0, last ? 32 : 36, 1); S.pk2 = pg8::mkpk(32, 4, 6, 6, 0); S.pk3 = pg8::mkpk(0, 6, 32, 4, 1);
            S.st1 = last ? 384 : 432; S.st2 = last ? 704 : 0x7fffffff; S.st3 = last ? 728 : 0x7fffffff; S.total = last ? 752 : 792;
            pg8::EpiWin E{ws, (float*)(ws + OFF_KSS) + (size_t)l * T * 12};
            pg8::gemm_phase(lds, tid, D, S, E);
            if (!last && bx >= 24) conv_range(lds, tid, p, CV_WI2_0, 5296, bx - 24, G - 24);
        } else {
            for (int drep = 0; drep < DFT_REP; ++drep)
            if (bx < 64 || (!last && bx < 72)) {
                const bool dl = bx < 64; const int K = dl ? 4096 : 512;
                const pg8::MSched S = pg8::sched1(dl ? DFTL : DFTC, dl ? UtL : UtC, dl ? 8 : 1, 8, dl ? 0 : 1, dl ? 64 : 8, dl ? bx : bx - 64, (size_t)256 * K * 2, K);
                pg8::EpiDft E{CAT};
#ifndef NO_G4
                pg8::gemm_phase(lds, tid, K, S, E);
#endif
            }
            if (bx < 64) { if (!last) conv_range(lds, tid, p, 5296, 5680, bx, 64); else conv_range(lds, tid, p, 9032, 9416, bx, 64); }
            for (int arep = 0; arep < ATT_REP; ++arep)
            if (bx >= 64) {
                const int nitems = last ? 768 : 768 + 96;
                const float* gq = p->q_norm_w + l * 128; const float* gk = p->k_norm_w + l * 128; const float* rpbl = p->rpb + (size_t)l * 12 * 465;
                for (int it = bx - 64; it < nitems; it += G - 64) {
                    int ab, ahp, ar, aqg; const bool actx = it >= 768;
                    if (!actx) { const int a = it % 192, x = a & 7, j = a >> 3; ahp = 3 * (x & 1) + j % 3; ar = 8 * (x >> 1) + j / 3; ab = it / 192; aqg = 0; }
                    else { const int j = it - 768; ahp = j % 6; aqg = (j / 6) & 3; ab = j / 24; ar = 0; }
                    attn_block(lds, tid, QK, VtL, VtC, CAT, gq, gk, rpbl, (const float*)(ws + OFF_KSS) + (size_t)l * T * 12, ab, ahp, ar, aqg, actx, it == bx - 64);
                }
            }
            if (!last) { if (bx >= 160) conv_range(lds, tid, p, 5680, 5936, bx - 160, 96); }
            else if (bx >= 64) conv_range(lds, tid, p, 9416, CV_WO2_1, bx - 64, G - 64);
        }
    }
}

extern "C" void kernel_launch(void* const* d_in, const int* in_sizes, int n_in, void* d_out, int out_size, void* d_ws, size_t ws_size, hipStream_t stream) {
    static int grid_blocks = 0;
    if (!grid_blocks) {
        int dev = 0, cus = 0, per_cu = 0;
        hipGetDevice(&dev);
        hipDeviceGetAttribute(&cus, hipDeviceAttributeMultiprocessorCount, dev);
        hipFuncSetAttribute((const void*)fwd_megakernel, hipFuncAttributeMaxDynamicSharedMemorySize, LDS_BYTES);
        hipOccupancyMaxActiveBlocksPerMultiprocessor(&per_cu, (const void*)fwd_megakernel, NTHR, LDS_BYTES);
        if (per_cu < 1) { fprintf(stderr, "occupancy query says %d blocks/CU\n", per_cu); per_cu = 1; }
        grid_blocks = cus * 1;
        if (ws_size < WS_END) fprintf(stderr, "workspace too small: %zu < %zu\n", ws_size, (size_t)WS_END);
    }
    Params p{};
    p.x = (const float*)d_in[0]; p.c = (const float*)d_in[1]; p.ctx = (const float*)d_in[2]; p.c_ctx = (const float*)d_in[3]; p.w_mod = (const float*)d_in[4]; p.b_mod = (const float*)d_in[5];
    p.norm_w = (const float*)d_in[6]; p.ffn1_wi = (const float*)d_in[7]; p.ffn1_wo = (const float*)d_in[8]; p.w_in = (const float*)d_in[9]; p.q_norm_w = (const float*)d_in[10];
    p.k_norm_w = (const float*)d_in[11]; p.rpb = (const float*)d_in[12]; p.w_four = (const float*)d_in[13]; p.w_out = (const float*)d_in[14]; p.ffn2_wi = (const float*)d_in[15]; p.ffn2_wo = (const float*)d_in[16];
    p.out = (float*)d_out; p.ws = (unsigned char*)d_ws;
    (void)hipMemsetAsync((char*)d_ws + OFF_BAR, 0, SZ_BAR + SZ_MOD + SZ_KSS, stream);
#if MULTI_LAUNCH
    for (int ph = 0; ph < 21; ++ph) { p.ph_lo = ph; p.ph_hi = ph + 1; hipLaunchKernelGGL(fwd_megakernel, dim3(grid_blocks), dim3(NTHR), LDS_BYTES, stream, p); }
#else
    p.ph_lo = 0; p.ph_hi = 21;
    void* args[] = {&p};
    hipError_t e = hipLaunchCooperativeKernel((const void*)fwd_megakernel, dim3(grid_blocks), dim3(NTHR), args, LDS_BYTES, stream);
    if (e != hipSuccess) fprintf(stderr, "cooperative launch failed: %s (grid %d)\n", hipGetErrorString(e), grid_blocks);
#endif
}
```
